# Optimizing an MI355X kernel written in HIP

```python
import math
import jax, jax.numpy as jnp
from jax import lax
import numpy as np


D_MODEL = 1024
BATCH = 8
SEQ = 8192
DEPTH = 1
DEC_BATCH = 2
DEC_SEQ = 16384
PAST_LEN = 128

A_HEADS = 4
A_QK_DIM = 64
A_V_DIM = 2 * A_QK_DIM
A_WIDTH = A_HEADS * A_V_DIM
A_ROPE_DIM = A_QK_DIM // 4
B_HEADS = 4
B_NOPE_DIM = 128
B_ROPE_DIM = 64
B_V_DIM = 128
B_WIDTH = B_HEADS * B_V_DIM
Q_LORA = 384
KV_LORA = 256
MIX_WIDTH = A_WIDTH + B_WIDTH
ROPE_THETA = 500000.0
NORM_EPS = 1e-6
Q_BLOCK = 128

IN_SPLIT = (2 * A_HEADS * A_QK_DIM,
            2 * A_HEADS * A_QK_DIM,
            A_WIDTH,
            A_WIDTH,
            Q_LORA,
            KV_LORA,
            B_ROPE_DIM,
            B_WIDTH)
IN_COLS = 2 * A_HEADS * A_QK_DIM * 2 + 2 * A_WIDTH + Q_LORA + KV_LORA + B_ROPE_DIM + B_WIDTH

kernel_name = 'hymba_diff_mla_encoder'


def rmsnorm(x, g):
    xf = x.astype(jnp.float32)
    y = xf * lax.rsqrt(jnp.mean(xf * xf, axis=-1, keepdims=True) + NORM_EPS)
    return (y * g.astype(jnp.float32)).astype(x.dtype)


def split_cols(x, sizes):
    idx = []
    acc = 0
    for n in sizes[:-1]:
        acc += n
        idx.append(acc)
    return jnp.split(x, idx, axis=-1)


def rope_tables(seq, dim):
    inv_freq = jnp.float32(ROPE_THETA) ** (-jnp.arange(0, dim, 2, dtype=jnp.float32) / dim)
    ang = jnp.arange(seq, dtype=jnp.float32)[:, None] * inv_freq[None, :]
    return jnp.cos(ang), jnp.sin(ang)


def apply_rope(x, cos, sin):
    half = x.shape[-1] // 2
    x1, x2 = x[..., :half], x[..., half:]
    cos = cos.astype(x.dtype)
    sin = sin.astype(x.dtype)
    return jnp.concatenate([x1 * cos - x2 * sin, x2 * cos + x1 * sin], axis=-1)


def sweep_query_blocks(block_fn, queries):
    b, s = queries[0].shape[:2]
    nb = s // Q_BLOCK
    blocks = tuple(jnp.moveaxis(q.reshape((b, nb, Q_BLOCK) + q.shape[2:]), 1, 0) for q in queries)
    out = lax.map(lambda qb: block_fn(*qb), blocks)
    out = jnp.moveaxis(out, 0, 1)
    return out.reshape((b, s) + out.shape[3:])


def diff_attention(q1, q2, k1, k2, v, lam):
    scale = A_QK_DIM ** -0.5

    def block(q1b, q2b):
        s1 = jnp.einsum('bqhd,bkhd->bhqk', q1b, k1).astype(jnp.float32) * scale
        s2 = jnp.einsum('bqhd,bkhd->bhqk', q2b, k2).astype(jnp.float32) * scale
        w = jax.nn.softmax(s1, axis=-1) - lam * jax.nn.softmax(s2, axis=-1)
        return jnp.einsum('bhqk,bkhe->bqhe', w.astype(v.dtype), v)

    return sweep_query_blocks(block, (q1, q2))


def mla_attention(qn, qr, kn, kr, v):
    scale = (B_NOPE_DIM + B_ROPE_DIM) ** -0.5

    def block(qnb, qrb):
        s = (jnp.einsum('bqhd,bkhd->bhqk', qnb, kn)
             + jnp.einsum('bqhr,bkr->bhqk', qrb, kr)).astype(jnp.float32) * scale
        p = jax.nn.softmax(s, axis=-1)
        return jnp.einsum('bhqk,bkhe->bqhe', p.astype(v.dtype), v)

    return sweep_query_blocks(block, (qn, qr))


def encoder_layer(x, c, layer, w_ada, b_ada, g_pre, w_in, lambda_q1, lambda_k1, lambda_q2, lambda_k2,
                  g_subln, g_cq, w_uq, g_ckv, w_ukv, w_out, g_post):
    b, s, _ = x.shape
    lambda_init = 0.8 - 0.6 * math.exp(-0.3 * layer)

    mod = jax.nn.silu(c) @ w_ada + b_ada
    shift, scale, gate = jnp.split(mod, 3, axis=-1)
    h = rmsnorm(x, g_pre) * (1 + scale[:, None, :]) + shift[:, None, :]

    proj = h @ w_in
    aq, ak, av, ag, cq, ckv, kr, bg = split_cols(proj, IN_SPLIT)

    cos_a, sin_a = rope_tables(s, A_ROPE_DIM)
    cos_a4, sin_a4 = cos_a[:, None, None, :], sin_a[:, None, None, :]
    aq = aq.reshape(b, s, A_HEADS, 2, A_QK_DIM)
    ak = ak.reshape(b, s, A_HEADS, 2, A_QK_DIM)
    aq = jnp.concatenate([apply_rope(aq[..., :A_ROPE_DIM], cos_a4, sin_a4), aq[..., A_ROPE_DIM:]], axis=-1)
    ak = jnp.concatenate([apply_rope(ak[..., :A_ROPE_DIM], cos_a4, sin_a4), ak[..., A_ROPE_DIM:]], axis=-1)
    av = av.reshape(b, s, A_HEADS, A_V_DIM)
    lam = (jnp.exp(jnp.sum(lambda_q1.astype(jnp.float32) * lambda_k1.astype(jnp.float32)))
           - jnp.exp(jnp.sum(lambda_q2.astype(jnp.float32) * lambda_k2.astype(jnp.float32)))
           + lambda_init)
    oa = diff_attention(aq[..., 0, :], aq[..., 1, :], ak[..., 0, :], ak[..., 1, :], av, lam)
    oa = rmsnorm(oa, g_subln) * (1.0 - lambda_init)
    ya = oa.reshape(b, s, A_WIDTH) * jax.nn.silu(ag)

    cos_b, sin_b = rope_tables(s, B_ROPE_DIM)
    q = (rmsnorm(cq, g_cq) @ w_uq).reshape(b, s, B_HEADS, B_NOPE_DIM + B_ROPE_DIM)
    qn, qr = q[..., :B_NOPE_DIM], q[..., B_NOPE_DIM:]
    qr = apply_rope(qr, cos_b[:, None, :], sin_b[:, None, :])
    kv = (rmsnorm(ckv, g_ckv) @ w_ukv).reshape(b, s, B_HEADS, B_NOPE_DIM + B_V_DIM)
    kn, vb = kv[..., :B_NOPE_DIM], kv[..., B_NOPE_DIM:]
    kr = apply_rope(kr, cos_b, sin_b)
    ob = mla_attention(qn, qr, kn, kr, vb)
    yb = ob.reshape(b, s, B_WIDTH) * jax.nn.silu(bg)

    out = jnp.concatenate([ya, yb], axis=-1) @ w_out
    return x + gate[:, None, :] * rmsnorm(out, g_post)


def setup_inputs(seed: int = 0) -> dict:
    key = jax.random.key(seed)
    ks = jax.random.split(key, 24)
    f32 = jnp.float32
    nrm = lambda k, shape, s: jax.random.normal(k, shape, f32) * s
    gain = lambda k, shape: 1.0 + 0.02 * jax.random.normal(k, shape, f32)
    L = DEPTH
    return {
        'x_prompt': nrm(ks[0], (BATCH, SEQ, D_MODEL), 1.0),
        'x_sample': nrm(ks[1], (DEC_BATCH, DEC_SEQ, D_MODEL), 1.0),
        'c_prompt': nrm(ks[2], (BATCH, D_MODEL), 1.0),
        'c_sample': nrm(ks[3], (DEC_BATCH, D_MODEL), 1.0),
        'w_ada': nrm(ks[4], (L, D_MODEL, 3 * D_MODEL), 0.3 * D_MODEL ** -0.5),
        'b_ada': nrm(ks[5], (L, 3 * D_MODEL), 0.01),
        'g_pre': gain(ks[6], (L, D_MODEL)),
        'w_in': nrm(ks[7], (L, D_MODEL, IN_COLS), D_MODEL ** -0.5),
        'lambda_q1': nrm(ks[8], (L, A_QK_DIM), 0.1),
        'lambda_k1': nrm(ks[9], (L, A_QK_DIM), 0.1),
        'lambda_q2': nrm(ks[10], (L, A_QK_DIM), 0.1),
        'lambda_k2': nrm(ks[11], (L, A_QK_DIM), 0.1),
        'g_subln': gain(ks[12], (L, A_V_DIM)),
        'g_cq': gain(ks[13], (L, Q_LORA)),
        'w_uq': nrm(ks[14], (L, Q_LORA, B_HEADS * (B_NOPE_DIM + B_ROPE_DIM)), Q_LORA ** -0.5),
        'g_ckv': gain(ks[15], (L, KV_LORA)),
        'w_ukv': nrm(ks[16], (L, KV_LORA, B_HEADS * (B_NOPE_DIM + B_V_DIM)), KV_LORA ** -0.5),
        'w_out': nrm(ks[17], (L, MIX_WIDTH, D_MODEL), MIX_WIDTH ** -0.5),
        'g_post': gain(ks[18], (L, D_MODEL)),
    }


def reference(x_prompt, x_sample, c_prompt, c_sample, w_ada, b_ada, g_pre, w_in, lambda_q1, lambda_k1,
              lambda_q2, lambda_k2, g_subln, g_cq, w_uq, g_ckv, w_ukv, w_out, g_post):
    y_prompt = x_prompt
    y_sample = x_sample
    for layer in range(DEPTH):
        lp = (w_ada[layer], b_ada[layer], g_pre[layer], w_in[layer], lambda_q1[layer], lambda_k1[layer],
              lambda_q2[layer], lambda_k2[layer], g_subln[layer], g_cq[layer], w_uq[layer], g_ckv[layer],
              w_ukv[layer], w_out[layer], g_post[layer])
        y_prompt = encoder_layer(y_prompt, c_prompt, layer, *lp)
        y_sample = encoder_layer(y_sample, c_sample, layer, *lp)
    return (y_prompt, y_sample)
```

```cpp
#include <hip/hip_runtime.h>
#include <hip/hip_bf16.h>
#include <hip/hip_cooperative_groups.h>
#include <cstdio>
#include <cstdint>
namespace cg = cooperative_groups;

using bf16 = __hip_bfloat16;
using bf16x8 = __attribute__((ext_vector_type(8))) short;
using s16x4  = __attribute__((ext_vector_type(4))) short;
using f32x16 = __attribute__((ext_vector_type(16))) float;
using u32x4  = __attribute__((ext_vector_type(4))) unsigned;

constexpr int SHM_V_ = 16384;
constexpr int DM = 1024, TP = 65536, TS = 32768, T = TP + TS, SP = 8192, SS = 16384;
constexpr int INC = 3264;
constexpr float EPS = 1e-6f;
constexpr float QSCALE_A = 0.125f * 1.4426950408889634f, QSCALE_B = 0.07216878364870322f * 1.4426950408889634f;
constexpr int NTHR = 512;
constexpr size_t MiB = 1ull << 20;
constexpr size_t OFF_H = 0, OFF_Y = 0, OFF_SBG = 192 * MiB, OFF_CQ = 288 * MiB, OFF_CKV = 360 * MiB, OFF_QB = 408 * MiB, OFF_KB = 552 * MiB,
                 OFF_VB = 696 * MiB, OFF_OUTB = 408 * MiB, OFF_WIN = 792 * MiB, OFF_WUQ = 800 * MiB, OFF_WUKV = 801 * MiB, OFF_WOUT = 802 * MiB,
                 OFF_ROPEA = 804 * MiB, OFF_ROPEB = 805 * MiB, OFF_MOD = 809 * MiB, OFF_LAM = 809 * MiB + 512 * 1024, OFF_SSQ = 810 * MiB,
                 OFF_SSKV = 815 * MiB, OFF_SSO = 818 * MiB, OFF_SCR = 830 * MiB;
constexpr size_t OFF_QA = 0, OFF_KA = 96 * MiB, OFF_VA = 192 * MiB, OFF_SAG = 288 * MiB;
constexpr int LDS_BYTES = 2 * SHM_V_ + 2 * 64 * 192 * 2 + 2048 + 8 * 8192;

struct Params {
  const float *x_prompt, *x_sample, *c_prompt, *c_sample, *w_ada, *b_ada, *g_pre, *w_in, *lq1, *lk1, *lq2, *lk2, *g_subln, *g_cq, *w_uq, *g_ckv,
      *w_ukv, *w_out, *g_post;
  float* out;
  char* ws;
};

#define SBAR() __builtin_amdgcn_sched_barrier(0)
__device__ __forceinline__ int crow(int r, int hi) { return (r & 3) + 8 * (r >> 2) + 4 * hi; }
__device__ __forceinline__ unsigned cvtpk(float lo, float hi) {
  unsigned r; asm volatile("v_cvt_pk_bf16_f32 %0, %1, %2" : "=v"(r) : "v"(lo), "v"(hi)); return r;
}
__device__ __forceinline__ void st4(bf16* p, float a, float b, float c, float d) { uint2 v; v.x = cvtpk(a, b); v.y = cvtpk(c, d); *reinterpret_cast<uint2*>(p) = v; }
__device__ __forceinline__ float silu_f(float v) { return v / (1.f + __expf(-v)); }
__device__ __forceinline__ float bf2f(unsigned short u) { return __uint_as_float(((unsigned)u) << 16); }
__device__ __forceinline__ float xor32_add(float v) {
  auto rr = __builtin_amdgcn_permlane32_swap(__float_as_uint(v), __float_as_uint(v), false, false);
  return __uint_as_float(rr[0]) + __uint_as_float(rr[1]);
}

struct TokInfo { int bmod, bb, S, s0, isS; };
__device__ __forceinline__ TokInfo tokinfo(int t0) {
  TokInfo ti;
  if (t0 < TP) { ti.isS = 0; ti.bb = t0 >> 13; ti.bmod = ti.bb; ti.S = SP; ti.s0 = t0 & (SP - 1); }
  else { int u = t0 - TP; ti.isS = 1; ti.bb = u >> 14; ti.bmod = 8 + ti.bb; ti.S = SS; ti.s0 = u & (SS - 1); }
  return ti;
}
__device__ __forceinline__ long rowV(const TokInfo& ti, int hd, int s) { return (ti.isS ? (long)TP * 4 : 0) + (long)(ti.bb * 4 + hd) * ti.S + s; }
__device__ __forceinline__ long rowA(const TokInfo& ti, int hd, int map, int s) { return (ti.isS ? (long)TP * 8 : 0) + (long)((ti.bb * 4 + hd) * 2 + map) * ti.S + s; }

template <int NT>
__device__ __forceinline__ void gemm_main(const bf16* __restrict__ Ag, const bf16* __restrict__ Bg, const int K, char* lds, f32x16 (&acc)[2][NT]) {
  constexpr int A_BYTES = NT * 64 * 128, STAGE = A_BYTES + 32768;
  int tid_ = threadIdx.x; asm volatile("" : "+v"(tid_));
  const int tid = tid_, lane = tid & 63, wid = tid >> 6, r32 = lane & 31, hi = lane >> 5, tw = wid >> 1, fw = wid & 1;
  const int srow = tid >> 3, scc = tid & 7;
  const int soff = srow * 128 + ((scc ^ ((srow >> 1) & 7)) << 4);
  const bf16* ag = Ag + (long)srow * K + scc * 8;
  const bf16* bg = Bg + (long)srow * K + scc * 8;
  const int key = (r32 >> 1) & 7;
  const int aoff = (fw * 32 * NT + r32) * 128, boff = A_BYTES + (tw * 64 + r32) * 128;
  bf16x8 ra0[NT], rb0[4], ra1[NT], rb1[4];
#pragma unroll
  for (int ti = 0; ti < 2; ++ti)
#pragma unroll
    for (int fi = 0; fi < NT; ++fi) acc[ti][fi] = f32x16{};
  const int KT = K >> 6;
#define GLOAD(RA, RB, kt) do { _Pragma("unroll") for (int i = 0; i < NT; ++i) RA[i] = *reinterpret_cast<const bf16x8*>(ag + (long)i * 64 * K + (kt) * 64); \
    _Pragma("unroll") for (int i = 0; i < 4; ++i) RB[i] = *reinterpret_cast<const bf16x8*>(bg + (long)i * 64 * K + (kt) * 64); } while (0)
#define GWRITE(buf, RA, RB) do { char* b_ = lds + (buf) * STAGE; _Pragma("unroll") for (int i = 0; i < NT; ++i) *reinterpret_cast<bf16x8*>(b_ + i * 8192 + soff) = RA[i]; \
    _Pragma("unroll") for (int i = 0; i < 4; ++i) *reinterpret_cast<bf16x8*>(b_ + A_BYTES + i * 8192 + soff) = RB[i]; } while (0)
#define GCOMP(buf) do { const char* base = lds + (buf) * STAGE; \
    _Pragma("unroll") for (int ks = 0; ks < 4; ++ks) { \
      const int ko = ((ks * 2 + hi) ^ key) << 4; \
      bf16x8 af[NT], bfr[2]; \
      _Pragma("unroll") for (int fi = 0; fi < NT; ++fi) af[fi] = *reinterpret_cast<const bf16x8*>(base + aoff + fi * 4096 + ko); \
      _Pragma("unroll") for (int ti = 0; ti < 2; ++ti) bfr[ti] = *reinterpret_cast<const bf16x8*>(base + boff + ti * 4096 + ko); \
      _Pragma("unroll") for (int ti = 0; ti < 2; ++ti) \
        _Pragma("unroll") for (int fi = 0; fi < NT; ++fi) acc[ti][fi] = __builtin_amdgcn_mfma_f32_32x32x16_bf16(af[fi], bfr[ti], acc[ti][fi], 0, 0, 0); \
    } } while (0)
  GLOAD(ra0, rb0, 0); GLOAD(ra1, rb1, 1);
  __syncthreads();
  GWRITE(0, ra0, rb0);
  __syncthreads();
  for (int kt = 0; kt < KT; kt += 2) {
    if (kt + 2 < KT) GLOAD(ra0, rb0, kt + 2);
    SBAR();
    GCOMP(0);
    GWRITE(1, ra1, rb1);
    __syncthreads();
    if (kt + 3 < KT) GLOAD(ra1, rb1, kt + 3);
    SBAR();
    GCOMP(1);
    if (kt + 2 < KT) GWRITE(0, ra0, rb0);
    __syncthreads();
  }
#undef GCOMP
#undef GLOAD
#undef GWRITE
}

__device__ __forceinline__ void store_tile(bf16* dst, const f32x16& a, int hi) {
#pragma unroll
  for (int g = 0; g < 4; ++g) st4(dst + 8 * g + 4 * hi, a[4 * g], a[4 * g + 1], a[4 * g + 2], a[4 * g + 3]);
}
__device__ __forceinline__ float sumsq16(const f32x16& a) { float s = 0;
#pragma unroll
  for (int r = 0; r < 16; ++r) s += a[r] * a[r];
  return s; }

__device__ __forceinline__ void p1_generic(const Params& p, f32x16& a, int nb, int tok, int s, const TokInfo& ti, int hi) {
  char* outc = (char*)p.out;
  if (nb < 1024) {
    const int isK = nb >= 512, c = nb & 511, hd = c >> 7, map = (c >> 6) & 1, dbase = c & 63;
    if (!isK) {
#pragma unroll
      for (int r = 0; r < 16; ++r) a[r] *= QSCALE_A;
    }
    if (dbase == 0) {
      const float4* rt = reinterpret_cast<const float4*>(p.ws + OFF_ROPEA) + ((long)s * 8 + 4 * hi) / 2;
      const float4 cs0 = rt[0], cs1 = rt[1];
      const float cc[4] = {cs0.x, cs0.z, cs1.x, cs1.z}, sn[4] = {cs0.y, cs0.w, cs1.y, cs1.w};
#pragma unroll
      for (int r = 0; r < 4; ++r) { const float x1 = a[r], x2 = a[r + 4]; a[r] = x1 * cc[r] - x2 * sn[r]; a[r + 4] = x2 * cc[r] + x1 * sn[r]; }
    }
    bf16* dst = (bf16*)(outc + (isK ? OFF_KA : OFF_QA)) + rowA(ti, hd, map, s) * 64 + dbase;
    store_tile(dst, a, hi);
  } else if (nb < 1536) {
    const int c = nb - 1024, hd = c >> 7, col = c & 127;
    store_tile((bf16*)(outc + OFF_VA) + rowV(ti, hd, s) * 128 + col, a, hi);
  } else if (nb < 2048) {
#pragma unroll
    for (int r = 0; r < 16; ++r) a[r] = silu_f(a[r]);
    store_tile((bf16*)(outc + OFF_SAG) + (long)tok * 512 + (nb - 1536), a, hi);
  } else if (nb < 2432) {
    const float ss = xor32_add(sumsq16(a));
    if (hi == 0) reinterpret_cast<float*>(p.ws + OFF_SSQ)[(long)tok * 12 + ((nb - 2048) >> 5)] = ss;
    store_tile((bf16*)(p.ws + OFF_CQ) + (long)tok * 384 + (nb - 2048), a, hi);
  } else if (nb < 2688) {
    const float ss = xor32_add(sumsq16(a));
    if (hi == 0) reinterpret_cast<float*>(p.ws + OFF_SSKV)[(long)tok * 8 + ((nb - 2432) >> 5)] = ss;
    store_tile((bf16*)(p.ws + OFF_CKV) + (long)tok * 256 + (nb - 2432), a, hi);
  } else if (nb >= 2752) {
#pragma unroll
    for (int r = 0; r < 16; ++r) a[r] = silu_f(a[r]);
    store_tile((bf16*)(p.ws + OFF_SBG) + (long)tok * 512 + (nb - 2752), a, hi);
  }
}
__device__ __forceinline__ void rope64(const Params& p, f32x16& a0, f32x16& a1, int s, int hi, float rs) {
#pragma unroll
  for (int g = 0; g < 4; ++g) {
    const float4* rt = reinterpret_cast<const float4*>(p.ws + OFF_ROPEB) + ((long)s * 32 + 8 * g + 4 * hi) / 2;
    const float4 cs0 = rt[0], cs1 = rt[1];
    const float cc[4] = {cs0.x, cs0.z, cs1.x, cs1.z}, sn[4] = {cs0.y, cs0.w, cs1.y, cs1.w};
#pragma unroll
    for (int q = 0; q < 4; ++q) { const int r = 4 * g + q; const float x1 = a0[r] * rs, x2 = a1[r] * rs; a0[r] = x1 * cc[q] - x2 * sn[q]; a1[r] = x2 * cc[q] + x1 * sn[q]; }
  }
}

__device__ __forceinline__ void phase1_tile(const Params& p, int tt, int ft, char* lds) {
  const int n0 = ft * 192, t0 = tt * 256;
  f32x16 acc[2][3];
  gemm_main<3>((const bf16*)(p.ws + OFF_WIN) + (long)n0 * DM, (const bf16*)(p.ws + OFF_H) + (long)t0 * DM, DM, lds, acc);
  const int tid = threadIdx.x, lane = tid & 63, wid = __builtin_amdgcn_readfirstlane(tid >> 6), r32 = lane & 31, hi = lane >> 5, tw = wid >> 1, fw = wid & 1;
  const TokInfo ti = tokinfo(t0);
#pragma unroll
  for (int tq = 0; tq < 2; ++tq) {
    const int tok = t0 + tw * 64 + tq * 32 + r32, s = ti.s0 + tw * 64 + tq * 32 + r32;
    if (n0 == 2688 && fw == 0) {
      rope64(p, acc[tq][0], acc[tq][1], s, hi, 1.f);
#pragma unroll
      for (int hd = 0; hd < 4; ++hd) {
        bf16* dst = (bf16*)(p.ws + OFF_KB) + rowV(ti, hd, s) * 192 + 128;
        store_tile(dst, acc[tq][0], hi); store_tile(dst + 32, acc[tq][1], hi);
      }
      p1_generic(p, acc[tq][2], n0 + 64, tok, s, ti, hi);
    } else {
#pragma unroll
      for (int fi = 0; fi < 3; ++fi) p1_generic(p, acc[tq][fi], n0 + fw * 96 + fi * 32, tok, s, ti, hi);
    }
  }
}

__device__ __forceinline__ void phase1b_tile(const Params& p, int tt, int f, char* lds) {
  const int t0 = tt * 256;
  f32x16 acc[2][4];
  const bool isQ = f < 3;
  const int n0 = (isQ ? f : f - 3) * 256;
  if (isQ) gemm_main<4>((const bf16*)(p.ws + OFF_WUQ) + (long)n0 * 384, (const bf16*)(p.ws + OFF_CQ) + (long)t0 * 384, 384, lds, acc);
  else     gemm_main<4>((const bf16*)(p.ws + OFF_WUKV) + (long)n0 * 256, (const bf16*)(p.ws + OFF_CKV) + (long)t0 * 256, 256, lds, acc);
  int tid_ = threadIdx.x; asm volatile("" : "+v"(tid_));
  const int tid = tid_, lane = tid & 63, wid = __builtin_amdgcn_readfirstlane(tid >> 6), r32 = lane & 31, hi = lane >> 5, tw = wid >> 1, fw = wid & 1;
  const TokInfo ti = tokinfo(t0);
#pragma unroll
  for (int tq = 0; tq < 2; ++tq) {
    const int tok = t0 + tw * 64 + tq * 32 + r32, s = ti.s0 + tw * 64 + tq * 32 + r32;
    float rs;
    if (isQ) { const float4* q4 = reinterpret_cast<const float4*>(p.ws + OFF_SSQ) + (long)tok * 3; const float4 a = q4[0], b = q4[1], c = q4[2];
      rs = rsqrtf((a.x + a.y + a.z + a.w + b.x + b.y + b.z + b.w + c.x + c.y + c.z + c.w) * (1.f / 384.f) + EPS) * QSCALE_B; }
    else { const float4* q4 = reinterpret_cast<const float4*>(p.ws + OFF_SSKV) + (long)tok * 2; const float4 a = q4[0], b = q4[1];
      rs = rsqrtf((a.x + a.y + a.z + a.w + b.x + b.y + b.z + b.w) * (1.f / 256.f) + EPS); }
#pragma unroll
    for (int gi = 0; gi < 2; ++gi) {
      const int nw = n0 + fw * 128 + gi * 64;
      f32x16& a0 = acc[tq][2 * gi]; f32x16& a1 = acc[tq][2 * gi + 1];
      if (isQ) {
        const int hd = nw / 192, c = nw - hd * 192;
        bf16* dst = (bf16*)(p.ws + OFF_QB) + rowV(ti, hd, s) * 192 + c;
        if (c == 128) rope64(p, a0, a1, s, hi, rs);
        else {
#pragma unroll
          for (int r = 0; r < 16; ++r) { a0[r] *= rs; a1[r] *= rs; }
        }
        store_tile(dst, a0, hi); store_tile(dst + 32, a1, hi);
      } else {
        const int hd = nw >> 8, c = nw & 255;
#pragma unroll
        for (int r = 0; r < 16; ++r) { a0[r] *= rs; a1[r] *= rs; }
        bf16* dst = (c < 128) ? (bf16*)(p.ws + OFF_KB) + rowV(ti, hd, s) * 192 + c : (bf16*)(p.ws + OFF_VB) + rowV(ti, hd, s) * 128 + (c - 128);
        store_tile(dst, a0, hi); store_tile(dst + 32, a1, hi);
      }
    }
  }
}

__device__ __forceinline__ void phase3_tile(const Params& p, int tt, int f, char* lds) {
  const int t0 = tt * 256, n0 = f * 256;
  f32x16 acc[2][4];
  gemm_main<4>((const bf16*)(p.ws + OFF_WOUT) + (long)n0 * DM, (const bf16*)(p.ws + OFF_Y) + (long)t0 * DM, DM, lds, acc);
  int tid_ = threadIdx.x; asm volatile("" : "+v"(tid_));
  const int tid = tid_, lane = tid & 63, wid = __builtin_amdgcn_readfirstlane(tid >> 6), r32 = lane & 31, hi = lane >> 5, tw = wid >> 1, fw = wid & 1;
#pragma unroll
  for (int tq = 0; tq < 2; ++tq) {
    const int tok = t0 + tw * 64 + tq * 32 + r32;
#pragma unroll
    for (int fi = 0; fi < 4; ++fi) {
      const int nb = n0 + fw * 128 + fi * 32;
      const float ss = xor32_add(sumsq16(acc[tq][fi]));
      if (hi == 0) reinterpret_cast<float*>(p.ws + OFF_SSO)[(long)tok * 32 + (nb >> 5)] = ss;
      store_tile((bf16*)(p.ws + OFF_OUTB) + (long)tok * DM + nb, acc[tq][fi], hi);
    }
  }
}

constexpr int SHM_V = 64 * 128 * 2;
constexpr float THR = 8.f;
template <int DQK> struct AC {
  static constexpr int KROWB = DQK * 2, SHM_K = 64 * DQK * 2, NKC = DQK / 64, ND0 = DQK / 16;
  static constexpr float SCALE = (DQK == 64) ? 0.125f : 0.07216878364870322f;
};
template <int DQK> __device__ __forceinline__ int kswz(int row, int cb) { return row * (DQK * 2) + (cb ^ (((row >> 1) & 7) << 4)); }

template <int DQK>
__device__ __forceinline__ void partialSM(f32x16& p0, f32x16& p1, float& m_reg, float& mn, float& alpha) {
  constexpr float SCALE = AC<DQK>::SCALE, C = SCALE * 1.4426950408889634f;
  float pmax = p0[0];
#pragma unroll
  for (int r = 1; r < 16; ++r) pmax = fmaxf(pmax, p0[r]);
#pragma unroll
  for (int r = 0; r < 16; ++r) pmax = fmaxf(pmax, p1[r]);
  { auto rr = __builtin_amdgcn_permlane32_swap(__float_as_uint(pmax), __float_as_uint(pmax), false, false);
    pmax = fmaxf(__uint_as_float(rr[0]), __uint_as_float(rr[1])); }
  if (__builtin_expect(__all(pmax - m_reg <= THR / SCALE), 1)) { mn = m_reg; alpha = 1.f; }
  else { mn = fmaxf(m_reg, pmax); alpha = __builtin_amdgcn_exp2f((m_reg - mn) * C); m_reg = mn; }
  const float mnC = -mn * C;
#pragma unroll
  for (int r = 0; r < 16; ++r) p0[r] = fmaf(p0[r], C, mnC);
#pragma unroll
  for (int r = 0; r < 16; ++r) p1[r] = fmaf(p1[r], C, mnC);
#pragma unroll
  for (int r = 0; r < 16; ++r) p0[r] = __builtin_amdgcn_exp2f(p0[r]);
}
__device__ __forceinline__ void finishSM(f32x16& p0, f32x16& p1, float alpha, float& l_reg, bf16x8& pa0, bf16x8& pa1, bf16x8& pa2, bf16x8& pa3) {
#pragma unroll
  for (int r = 0; r < 16; ++r) p1[r] = __builtin_amdgcn_exp2f(p1[r]);
  float ps = 0;
#pragma unroll
  for (int r = 0; r < 16; ++r) ps += p0[r];
#pragma unroll
  for (int r = 0; r < 16; ++r) ps += p1[r];
  ps = xor32_add(ps);
  l_reg = l_reg * alpha + ps;
#define PK4(P, BASE, OUT) do { u32x4 w = {cvtpk(P[BASE + 0], P[BASE + 1]), cvtpk(P[BASE + 2], P[BASE + 3]), cvtpk(P[BASE + 4], P[BASE + 5]), cvtpk(P[BASE + 6], P[BASE + 7])}; \
    OUT = *reinterpret_cast<bf16x8*>(&w); } while (0)
  PK4(p0, 0, pa0); PK4(p0, 8, pa1); PK4(p1, 0, pa2); PK4(p1, 8, pa3);
#undef PK4
}
template <int DQK, int NQR>
__device__ __forceinline__ void qkt(f32x16& p0, f32x16& p1, const char* Ks, const bf16x8* qr, const char* ql, int r32, int hi) {
  p0 = f32x16{}; p1 = f32x16{};
  const int kx = ((r32 >> 1) & 7) << 4, rb = r32 * (DQK * 2);
  const char* kb0 = Ks + rb + ((0 * 32 + hi * 16) ^ kx); const char* kb1 = Ks + rb + ((1 * 32 + hi * 16) ^ kx);
  const char* kb2 = Ks + rb + ((2 * 32 + hi * 16) ^ kx); const char* kb3 = Ks + rb + ((3 * 32 + hi * 16) ^ kx);
  constexpr int ND = DQK / 16, LOOK = 2;
  bf16x8 fa[ND], fb[ND];
#define KLD(d) do { const char* kb_ = (((d) & 3) == 0 ? kb0 : ((d) & 3) == 1 ? kb1 : ((d) & 3) == 2 ? kb2 : kb3) + ((d) >> 2) * 128; \
    fa[d] = *reinterpret_cast<const bf16x8*>(kb_); fb[d] = *reinterpret_cast<const bf16x8*>(kb_ + 32 * (DQK * 2)); } while (0)
#pragma unroll
  for (int d0 = 0; d0 < LOOK && d0 < ND; ++d0) KLD(d0);
#pragma unroll
  for (int d0 = 0; d0 < ND; ++d0) {
    if (d0 + LOOK < ND) KLD(d0 + LOOK);
    bf16x8 q;
    if (d0 < NQR) q = qr[d0]; else q = *reinterpret_cast<const bf16x8*>(ql + (d0 - NQR) * 8192);
    p0 = __builtin_amdgcn_mfma_f32_32x32x16_bf16(fa[d0], q, p0, 0, 0, 0);
    p1 = __builtin_amdgcn_mfma_f32_32x32x16_bf16(fb[d0], q, p1, 0, 0, 0);
    SBAR(); }
#undef KLD
}
template <int DQK>
__device__ __forceinline__ void kfrag(const char* Ks, int d, int r32, int hi, bf16x8& fa, bf16x8& fb) {
  const int kx = ((r32 >> 1) & 7) << 4, rb = r32 * (DQK * 2);
  const char* kb_ = Ks + rb + (((d & 3) * 32 + hi * 16) ^ kx) + (d >> 2) * 128;
  fa = *reinterpret_cast<const bf16x8*>(kb_); fb = *reinterpret_cast<const bf16x8*>(kb_ + 32 * (DQK * 2));
}
template <int DQK>
__device__ __forceinline__ void qkt_pre(f32x16& p0, f32x16& p1, const char* Ks, const bf16x8* qr, const bf16x8 (&pf)[4], int r32, int hi) {
  constexpr int ND = DQK / 16;
  bf16x8 fa[ND], fb[ND];
  fa[0] = pf[0]; fb[0] = pf[1]; fa[1] = pf[2]; fb[1] = pf[3];
  p0 = f32x16{}; p1 = f32x16{};
#pragma unroll
  for (int d0 = 0; d0 < ND; ++d0) {
    if (d0 + 2 < ND) kfrag<DQK>(Ks, d0 + 2, r32, hi, fa[d0 + 2], fb[d0 + 2]);
    p0 = __builtin_amdgcn_mfma_f32_32x32x16_bf16(fa[d0], qr[d0], p0, 0, 0, 0);
    p1 = __builtin_amdgcn_mfma_f32_32x32x16_bf16(fb[d0], qr[d0], p1, 0, 0, 0);
    SBAR(); }
}
__device__ __forceinline__ int v_st(int k, int c) { const int kk = k;   return ((kk >> 3) * 4 + (c >> 5)) * 512 + ((kk & 7) * 32 + (c & 31)) * 2; }
__device__ __forceinline__ int v_rd_base(int lane) { return ((lane & 3) << 3) | (((lane >> 2) & 3) << 6) | (((lane >> 4) & 1) << 5) | (((lane >> 5) & 1) << 8); }
constexpr int v_rd_off(int d0, int ks, int half) { return d0 * 512 + ks * 4096 + half * 2048; }
template <int OFF> __device__ __forceinline__ s16x4 tr_read(int vb) {
  return __builtin_amdgcn_ds_read_tr16_b64_v4i16((__attribute__((address_space(3))) s16x4*)(uintptr_t)(unsigned)(vb + OFF));
}
template <int D0> __device__ __forceinline__ void pv_one(f32x16& od, int vb, bf16x8 pa0, bf16x8 pa1, bf16x8 pa2, bf16x8 pa3) {
  const s16x4 l0 = tr_read<v_rd_off(D0, 0, 0)>(vb), h0 = tr_read<v_rd_off(D0, 0, 1)>(vb), l1 = tr_read<v_rd_off(D0, 1, 0)>(vb), h1 = tr_read<v_rd_off(D0, 1, 1)>(vb);
  const s16x4 l2 = tr_read<v_rd_off(D0, 2, 0)>(vb), h2 = tr_read<v_rd_off(D0, 2, 1)>(vb), l3 = tr_read<v_rd_off(D0, 3, 0)>(vb), h3 = tr_read<v_rd_off(D0, 3, 1)>(vb);
  asm volatile("s_waitcnt lgkmcnt(0)" ::: "memory"); SBAR();
#define PK(L, H) (bf16x8){L[0], L[1], L[2], L[3], H[0], H[1], H[2], H[3]}
  od = __builtin_amdgcn_mfma_f32_32x32x16_bf16(pa0, PK(l0, h0), od, 0, 0, 0);
  od = __builtin_amdgcn_mfma_f32_32x32x16_bf16(pa1, PK(l1, h1), od, 0, 0, 0);
  od = __builtin_amdgcn_mfma_f32_32x32x16_bf16(pa2, PK(l2, h2), od, 0, 0, 0);
  od = __builtin_amdgcn_mfma_f32_32x32x16_bf16(pa3, PK(l3, h3), od, 0, 0, 0);
#undef PK
}
template <int KS> __device__ __forceinline__ void pv_ks(f32x16* o, int vb, bf16x8 pa) {
  const s16x4 l0 = tr_read<v_rd_off(0, KS, 0)>(vb), h0 = tr_read<v_rd_off(0, KS, 1)>(vb), l1 = tr_read<v_rd_off(1, KS, 0)>(vb), h1 = tr_read<v_rd_off(1, KS, 1)>(vb);
  const s16x4 l2 = tr_read<v_rd_off(2, KS, 0)>(vb), h2 = tr_read<v_rd_off(2, KS, 1)>(vb), l3 = tr_read<v_rd_off(3, KS, 0)>(vb), h3 = tr_read<v_rd_off(3, KS, 1)>(vb);
  asm volatile("s_waitcnt lgkmcnt(0)" ::: "memory"); SBAR();
#define PK(L, H) (bf16x8){L[0], L[1], L[2], L[3], H[0], H[1], H[2], H[3]}
  o[0] = __builtin_amdgcn_mfma_f32_32x32x16_bf16(pa, PK(l0, h0), o[0], 0, 0, 0);
  o[1] = __builtin_amdgcn_mfma_f32_32x32x16_bf16(pa, PK(l1, h1), o[1], 0, 0, 0);
  o[2] = __builtin_amdgcn_mfma_f32_32x32x16_bf16(pa, PK(l2, h2), o[2], 0, 0, 0);
  o[3] = __builtin_amdgcn_mfma_f32_32x32x16_bf16(pa, PK(l3, h3), o[3], 0, 0, 0);
#undef PK
}
template <int KS> __device__ __forceinline__ void trk(int vb, s16x4 (&t)[8]) {
  t[0] = tr_read<v_rd_off(0, KS, 0)>(vb); t[1] = tr_read<v_rd_off(0, KS, 1)>(vb); t[2] = tr_read<v_rd_off(1, KS, 0)>(vb); t[3] = tr_read<v_rd_off(1, KS, 1)>(vb);
  t[4] = tr_read<v_rd_off(2, KS, 0)>(vb); t[5] = tr_read<v_rd_off(2, KS, 1)>(vb); t[6] = tr_read<v_rd_off(3, KS, 0)>(vb); t[7] = tr_read<v_rd_off(3, KS, 1)>(vb);
}
__device__ __forceinline__ void mfk(f32x16* o, const s16x4 (&t)[8], bf16x8 pa) {
#define PK(L, H) (bf16x8){L[0], L[1], L[2], L[3], H[0], H[1], H[2], H[3]}
  o[0] = __builtin_amdgcn_mfma_f32_32x32x16_bf16(pa, PK(t[0], t[1]), o[0], 0, 0, 0);
  o[1] = __builtin_amdgcn_mfma_f32_32x32x16_bf16(pa, PK(t[2], t[3]), o[1], 0, 0, 0);
  o[2] = __builtin_amdgcn_mfma_f32_32x32x16_bf16(pa, PK(t[4], t[5]), o[2], 0, 0, 0);
  o[3] = __builtin_amdgcn_mfma_f32_32x32x16_bf16(pa, PK(t[6], t[7]), o[3], 0, 0, 0);
#undef PK
}
__device__ __forceinline__ void pv_pre(f32x16* o, int vb, s16x4 (&ta)[8], bf16x8 pa0, bf16x8 pa1, bf16x8 pa2, bf16x8 pa3) {
  s16x4 tb[8];
  trk<1>(vb, tb); SBAR(); mfk(o, ta, pa0); SBAR();
  trk<2>(vb, ta); SBAR(); mfk(o, tb, pa1); SBAR();
  trk<3>(vb, tb); SBAR(); mfk(o, ta, pa2); SBAR();
  mfk(o, tb, pa3);
}
__device__ __forceinline__ void pv_d0(f32x16* o, int vb, bf16x8 pa0, bf16x8 pa1, bf16x8 pa2, bf16x8 pa3) {
  s16x4 ta[8]; trk<0>(vb, ta); pv_pre(o, vb, ta, pa0, pa1, pa2, pa3);
}

template <int DQK, int SDEPTH, int NQR>
__device__ __forceinline__ void attn_body(const bf16* __restrict__ Qb, const bf16* __restrict__ Kh, const bf16* __restrict__ Vh, int seq, char* lds, float* __restrict__ Ow) {
  constexpr int SHM_K = AC<DQK>::SHM_K, NKC = AC<DQK>::NKC, ND0 = AC<DQK>::ND0, NL = NKC + 2;
  int tid_ = threadIdx.x; asm volatile("" : "+v"(tid_));
  const int tid = tid_, wid = tid >> 6, lane = tid & 63, r32 = lane & 31, hi = lane >> 5;
  char* V_lds = lds; char* K_lds = lds + 2 * SHM_V;
  float* wsf = (float*)(lds + 2 * SHM_V + 2 * SHM_K) + wid * 64; float* li_l = wsf; float* al_l = wsf + 32;
  float m_reg = -1e30f, l_reg = 0; bf16x8 qr[NQR]; f32x16 o[4];
  char* ql = lds + 2 * SHM_V + 2 * SHM_K + 2048 + tid * 16;
#pragma unroll
  for (int d = 0; d < 4; ++d) o[d] = f32x16{};
  const bf16* Qw = Qb + (long)(wid * 32 + r32) * DQK + hi * 8;
#pragma unroll
  for (int d0 = 0; d0 < NQR; ++d0) qr[d0] = *reinterpret_cast<const bf16x8*>(Qw + d0 * 16);
  int kso[NKC];
#pragma unroll
  for (int i = 0; i < NKC; ++i) { const int c = tid + i * 512, row = c / (DQK / 8), cc = c % (DQK / 8); kso[i] = kswz<DQK>(row, cc * 16); }
  const int vst0 = v_st(tid >> 4, (tid & 15) * 8), vst1 = v_st(32 + (tid >> 4), (tid & 15) * 8);
  const int vb0 = (int)(uintptr_t)V_lds + v_rd_base(lane);
  struct { bf16x8 v0, v1, k[NKC]; } sr_[SDEPTH];
#define SLOAD(i, k0) do { const bf16* vp_ = Vh + (long)(k0) * 128 + tid * 8; sr_[i].v0 = *reinterpret_cast<const bf16x8*>(vp_); sr_[i].v1 = *reinterpret_cast<const bf16x8*>(vp_ + 4096); \
    const bf16* kp_ = Kh + (long)(k0) * DQK + tid * 8; _Pragma("unroll") for (int q_ = 0; q_ < NKC; ++q_) sr_[i].k[q_] = *reinterpret_cast<const bf16x8*>(kp_ + q_ * 4096); } while (0)
#define SWRITE(b, i) do { *reinterpret_cast<bf16x8*>(V_lds + (b) * SHM_V + vst0) = sr_[i].v0; *reinterpret_cast<bf16x8*>(V_lds + (b) * SHM_V + vst1) = sr_[i].v1; \
    _Pragma("unroll") for (int q_ = 0; q_ < NKC; ++q_) *reinterpret_cast<bf16x8*>(K_lds + (b) * SHM_K + kso[q_]) = sr_[i].k[q_]; } while (0)
#define SWAIT() do { if constexpr (SDEPTH == 2) { if constexpr (NL == 3) asm volatile("s_waitcnt vmcnt(3)" ::: "memory"); else asm volatile("s_waitcnt vmcnt(5)" ::: "memory"); } \
    else asm volatile("s_waitcnt vmcnt(0)" ::: "memory"); } while (0)
#define RESC(a) do { if (__any((a) < 1.f)) { if (hi == 0) al_l[r32] = (a); asm volatile("s_waitcnt lgkmcnt(0)" ::: "memory"); \
    _Pragma("unroll") for (int d = 0; d < 4; ++d) _Pragma("unroll") for (int r = 0; r < 16; ++r) o[d][r] *= al_l[crow(r, hi)]; } } while (0)
  f32x16 pA0, pA1, pB0, pB1; float mnA, mnB, alA, alB; bf16x8 pa0, pa1, pa2, pa3; const int NTL = seq / 64;
  constexpr int SE = 0, SO = SDEPTH - 1;
  __syncthreads();
#pragma unroll
  for (int d0 = NQR; d0 < ND0; ++d0) *reinterpret_cast<bf16x8*>(ql + (d0 - NQR) * 8192) = *reinterpret_cast<const bf16x8*>(Qw + d0 * 16);
  SLOAD(SE, 0); asm volatile("s_waitcnt vmcnt(0)" ::: "memory"); SWRITE(0, SE); __syncthreads();
  qkt<DQK, NQR>(pA0, pA1, K_lds, qr, ql, r32, hi); partialSM<DQK>(pA0, pA1, m_reg, mnA, alA);
  SLOAD(SO, 64); if constexpr (SDEPTH == 2) { if (2 < NTL) SLOAD(SE, 128); }
  SWAIT(); SWRITE(1, SO); __syncthreads();
  for (int j = 1; j + 1 < NTL; j += 2) {
    SBAR(); qkt<DQK, NQR>(pB0, pB1, K_lds + SHM_K, qr, ql, r32, hi);
    finishSM(pA0, pA1, alA, l_reg, pa0, pa1, pa2, pa3); SBAR();
    SLOAD(SO, (j + SDEPTH) * 64); SBAR();
    pv_d0(o, vb0, pa0, pa1, pa2, pa3); partialSM<DQK>(pB0, pB1, m_reg, mnB, alB);
    __syncthreads(); SWAIT(); SWRITE(0, SE);
    RESC(alB); __syncthreads();
    SBAR(); qkt<DQK, NQR>(pA0, pA1, K_lds, qr, ql, r32, hi);
    finishSM(pB0, pB1, alB, l_reg, pa0, pa1, pa2, pa3); SBAR();
    if (SDEPTH == 1 || j + 3 < NTL) SLOAD(SE, (j + 1 + SDEPTH) * 64); SBAR();
    pv_d0(o, vb0 + SHM_V, pa0, pa1, pa2, pa3); partialSM<DQK>(pA0, pA1, m_reg, mnA, alA);
    __syncthreads(); SWAIT(); SWRITE(1, SO);
    RESC(alA); __syncthreads();
  }
  SBAR(); qkt<DQK, NQR>(pB0, pB1, K_lds + SHM_K, qr, ql, r32, hi);
  finishSM(pA0, pA1, alA, l_reg, pa0, pa1, pa2, pa3); SBAR();
  pv_d0(o, vb0, pa0, pa1, pa2, pa3); partialSM<DQK>(pB0, pB1, m_reg, mnB, alB);
  __syncthreads(); RESC(alB);
  finishSM(pB0, pB1, alB, l_reg, pa0, pa1, pa2, pa3); SBAR();
  pv_d0(o, vb0 + SHM_V, pa0, pa1, pa2, pa3);
  if (hi == 0) li_l[r32] = l_reg;
  asm volatile("s_waitcnt lgkmcnt(0)" ::: "memory");
  float* Owv = Ow + (wid * 32 + 4 * hi) * 128 + r32;
  asm volatile("" : "+v"(Owv));
#pragma unroll
  for (int r = 0; r < 16; ++r) { const float rl = __builtin_amdgcn_rcpf(li_l[crow(r, hi)]);
#pragma unroll
    for (int d = 0; d < 4; ++d) Owv[crow(r, 0) * 128 + d * 32] = o[d][r] * rl; }
#undef SLOAD
#undef SWRITE
#undef SWAIT
#undef RESC
}

template <int DQK, int NQR>
__device__ __forceinline__ void attn_body_simple(const bf16* __restrict__ Qb, const bf16* __restrict__ Kh, const bf16* __restrict__ Vh, int seq, char* lds, float* __restrict__ Ow) {
  constexpr int SHM_K = AC<DQK>::SHM_K, NKC = AC<DQK>::NKC, ND0 = AC<DQK>::ND0;
  int tid_ = threadIdx.x; asm volatile("" : "+v"(tid_));
  const int tid = tid_, wid = tid >> 6, lane = tid & 63, r32 = lane & 31, hi = lane >> 5;
  char* V_lds = lds; char* K_lds = lds + 2 * SHM_V;
  float* wsf = (float*)(lds + 2 * SHM_V + 2 * SHM_K) + wid * 64; float* li_l = wsf; float* al_l = wsf + 32;
  float m_reg = -1e30f, l_reg = 0; bf16x8 qr[NQR]; f32x16 o[4];
  char* ql = lds + 2 * SHM_V + 2 * SHM_K + 2048 + tid * 16;
#pragma unroll
  for (int d = 0; d < 4; ++d) o[d] = f32x16{};
  const bf16* Qw = Qb + (long)(wid * 32 + r32) * DQK + hi * 8;
#pragma unroll
  for (int d0 = 0; d0 < NQR; ++d0) qr[d0] = *reinterpret_cast<const bf16x8*>(Qw + d0 * 16);
  int kso[NKC];
#pragma unroll
  for (int i = 0; i < NKC; ++i) { const int c = tid + i * 512, row = c / (DQK / 8), cc = c % (DQK / 8); kso[i] = kswz<DQK>(row, cc * 16); }
  const int vst0 = v_st(tid >> 4, (tid & 15) * 8), vst1 = v_st(32 + (tid >> 4), (tid & 15) * 8);
  const int vb0 = (int)(uintptr_t)V_lds + v_rd_base(lane);
  bf16x8 sv0, sv1, sk[NKC];
#define SLOAD(k0) do { const bf16* vp_ = Vh + (long)(k0) * 128 + tid * 8; sv0 = *reinterpret_cast<const bf16x8*>(vp_); sv1 = *reinterpret_cast<const bf16x8*>(vp_ + 4096); \
    const bf16* kp_ = Kh + (long)(k0) * DQK + tid * 8; _Pragma("unroll") for (int q_ = 0; q_ < NKC; ++q_) sk[q_] = *reinterpret_cast<const bf16x8*>(kp_ + q_ * 4096); } while (0)
#define SWRITE(b) do { *reinterpret_cast<bf16x8*>(V_lds + (b) * SHM_V + vst0) = sv0; *reinterpret_cast<bf16x8*>(V_lds + (b) * SHM_V + vst1) = sv1; \
    _Pragma("unroll") for (int q_ = 0; q_ < NKC; ++q_) *reinterpret_cast<bf16x8*>(K_lds + (b) * SHM_K + kso[q_]) = sk[q_]; } while (0)
#define RESC(a) do { if (__any((a) < 1.f)) { if (hi == 0) al_l[r32] = (a); asm volatile("s_waitcnt lgkmcnt(0)" ::: "memory"); \
    _Pragma("unroll") for (int d = 0; d < 4; ++d) _Pragma("unroll") for (int r = 0; r < 16; ++r) o[d][r] *= al_l[crow(r, hi)]; } } while (0)
  f32x16 p0, p1; float mn, al; bf16x8 pa0, pa1, pa2, pa3; const int NTL = seq / 64;
  __syncthreads();
#pragma unroll
  for (int d0 = NQR; d0 < ND0; ++d0) *reinterpret_cast<bf16x8*>(ql + (d0 - NQR) * 8192) = *reinterpret_cast<const bf16x8*>(Qw + d0 * 16);
  SLOAD(0); asm volatile("s_waitcnt vmcnt(0)" ::: "memory"); SWRITE(0); __syncthreads();
#pragma nounroll
  for (int j = 0; j < NTL; ++j) {
    const int b = j & 1;
    if (j + 1 < NTL) SLOAD((j + 1) * 64);
    SBAR(); qkt<DQK, NQR>(p0, p1, K_lds + b * SHM_K, qr, ql, r32, hi);
    partialSM<DQK>(p0, p1, m_reg, mn, al);
    RESC(al);
    finishSM(p0, p1, al, l_reg, pa0, pa1, pa2, pa3); SBAR();
    pv_d0(o, vb0 + b * SHM_V, pa0, pa1, pa2, pa3);
    if (j + 1 < NTL) SWRITE(b ^ 1);
    __syncthreads();
  }
  if (hi == 0) li_l[r32] = l_reg;
  asm volatile("s_waitcnt lgkmcnt(0)" ::: "memory");
  float* Owv = Ow + (wid * 32 + 4 * hi) * 128 + r32;
  asm volatile("" : "+v"(Owv));
#pragma unroll
  for (int r = 0; r < 16; ++r) { const float rl = __builtin_amdgcn_rcpf(li_l[crow(r, hi)]);
#pragma unroll
    for (int d = 0; d < 4; ++d) Owv[crow(r, 0) * 128 + d * 32] = o[d][r] * rl; }
#undef SLOAD
#undef SWRITE
#undef RESC
}

template <int D0> __device__ __forceinline__ void tr8(int vb, s16x4 (&t)[8]) {
  t[0] = tr_read<v_rd_off(D0, 0, 0)>(vb); t[1] = tr_read<v_rd_off(D0, 0, 1)>(vb); t[2] = tr_read<v_rd_off(D0, 1, 0)>(vb); t[3] = tr_read<v_rd_off(D0, 1, 1)>(vb);
  t[4] = tr_read<v_rd_off(D0, 2, 0)>(vb); t[5] = tr_read<v_rd_off(D0, 2, 1)>(vb); t[6] = tr_read<v_rd_off(D0, 3, 0)>(vb); t[7] = tr_read<v_rd_off(D0, 3, 1)>(vb);
}
__device__ __forceinline__ void mf4(f32x16& od, const s16x4 (&t)[8], bf16x8 pa0, bf16x8 pa1, bf16x8 pa2, bf16x8 pa3) {
#define PK(L, H) (bf16x8){L[0], L[1], L[2], L[3], H[0], H[1], H[2], H[3]}
  od = __builtin_amdgcn_mfma_f32_32x32x16_bf16(pa0, PK(t[0], t[1]), od, 0, 0, 0);
  od = __builtin_amdgcn_mfma_f32_32x32x16_bf16(pa1, PK(t[2], t[3]), od, 0, 0, 0);
  od = __builtin_amdgcn_mfma_f32_32x32x16_bf16(pa2, PK(t[4], t[5]), od, 0, 0, 0);
  od = __builtin_amdgcn_mfma_f32_32x32x16_bf16(pa3, PK(t[6], t[7]), od, 0, 0, 0);
#undef PK
}
__device__ __forceinline__ void pv_pipe(f32x16* o, int vb, bf16x8 pa0, bf16x8 pa1, bf16x8 pa2, bf16x8 pa3) {
  s16x4 ta[8], tb[8];
  tr8<0>(vb, ta);
  tr8<1>(vb, tb); asm volatile("s_waitcnt lgkmcnt(8)" ::: "memory"); SBAR(); mf4(o[0], ta, pa0, pa1, pa2, pa3); SBAR();
  tr8<2>(vb, ta); asm volatile("s_waitcnt lgkmcnt(8)" ::: "memory"); SBAR(); mf4(o[1], tb, pa0, pa1, pa2, pa3); SBAR();
  tr8<3>(vb, tb); asm volatile("s_waitcnt lgkmcnt(8)" ::: "memory"); SBAR(); mf4(o[2], ta, pa0, pa1, pa2, pa3); SBAR();
  asm volatile("s_waitcnt lgkmcnt(0)" ::: "memory"); SBAR(); mf4(o[3], tb, pa0, pa1, pa2, pa3);
}
constexpr float BIGSUM = 16384.f, BIG0 = 1.0995116e12f  , TINY0 = 9.094947e-13f  ;
template <int DQK>
__device__ __forceinline__ float softmax_nomax(f32x16& p0, f32x16& p1, float& m_reg, float& l_reg, bool& mzero, bool first, const char* Ks, const bf16x8* qr, int r32, int hi,
                                               bf16x8& pa0, bf16x8& pa1, bf16x8& pa2, bf16x8& pa3) {
  float alpha = 1.f, ps = 0.f; bool ok;
  if (mzero) {
#pragma unroll
    for (int r = 0; r < 16; ++r) { p0[r] = __builtin_amdgcn_exp2f(p0[r]); p1[r] = __builtin_amdgcn_exp2f(p1[r]); }
#pragma unroll
    for (int r = 0; r < 16; ++r) ps += p0[r];
#pragma unroll
    for (int r = 0; r < 16; ++r) ps += p1[r];
    ok = __all(ps <= BIG0 && (!first || ps >= TINY0));
  } else {
#pragma unroll
    for (int r = 0; r < 16; ++r) { p0[r] = __builtin_amdgcn_exp2f(p0[r] - m_reg); p1[r] = __builtin_amdgcn_exp2f(p1[r] - m_reg); }
#pragma unroll
    for (int r = 0; r < 16; ++r) ps += p0[r];
#pragma unroll
    for (int r = 0; r < 16; ++r) ps += p1[r];
    ok = __all(ps <= BIGSUM);
  }
  if (__builtin_expect(!ok, 0)) {
    qkt<DQK, DQK / 16>(p0, p1, Ks, qr, nullptr, r32, hi);
    float pmax = p0[0];
#pragma unroll
    for (int r = 1; r < 16; ++r) pmax = fmaxf(pmax, p0[r]);
#pragma unroll
    for (int r = 0; r < 16; ++r) pmax = fmaxf(pmax, p1[r]);
    { auto rr = __builtin_amdgcn_permlane32_swap(__float_as_uint(pmax), __float_as_uint(pmax), false, false);
      pmax = fmaxf(__uint_as_float(rr[0]), __uint_as_float(rr[1])); }
    const float mn = first ? pmax : fmaxf(m_reg, pmax);
    alpha = first ? 1.f : __builtin_amdgcn_exp2f(m_reg - mn); m_reg = mn; mzero = false;
    ps = 0.f;
#pragma unroll
    for (int r = 0; r < 16; ++r) { p0[r] = __builtin_amdgcn_exp2f(p0[r] - mn); p1[r] = __builtin_amdgcn_exp2f(p1[r] - mn); }
#pragma unroll
    for (int r = 0; r < 16; ++r) ps += p0[r] + p1[r];
  }
  l_reg = l_reg * alpha + ps;
#define PK4(P, BASE, OUT) do { u32x4 w = {cvtpk(P[BASE + 0], P[BASE + 1]), cvtpk(P[BASE + 2], P[BASE + 3]), cvtpk(P[BASE + 4], P[BASE + 5]), cvtpk(P[BASE + 6], P[BASE + 7])}; \
    OUT = *reinterpret_cast<bf16x8*>(&w); } while (0)
  PK4(p0, 0, pa0); PK4(p0, 8, pa1); PK4(p1, 0, pa2); PK4(p1, 8, pa3);
#undef PK4
  return alpha;
}
template <int DQK>
__device__ __forceinline__ void attn_body_stag(const bf16* __restrict__ Qb, const bf16* __restrict__ Kh, const bf16* __restrict__ Vh, int seq, char* lds, float* __restrict__ Ow) {
  constexpr int SHM_K = AC<DQK>::SHM_K, NKC = AC<DQK>::NKC, ND0 = AC<DQK>::ND0;
  int tid_ = threadIdx.x; asm volatile("" : "+v"(tid_));
  const int tid = tid_, wid = tid >> 6, lane = tid & 63, r32 = lane & 31, hi = lane >> 5;
  const int g = __builtin_amdgcn_readfirstlane(wid >> 2);
  char* V_lds = lds; char* K_lds = lds + 3 * SHM_V;
  float* wsf = (float*)(lds + 3 * SHM_V + 3 * SHM_K) + wid * 64; float* li_l = wsf; float* al_l = wsf + 32;
  float m_reg = 0.f, l_reg = 0; bool mzero = true; bf16x8 qr[ND0]; f32x16 o[4];
#pragma unroll
  for (int d = 0; d < 4; ++d) o[d] = f32x16{};
  const bf16* Qw = Qb + (long)(wid * 32 + r32) * DQK + hi * 8;
#pragma unroll
  for (int d0 = 0; d0 < ND0; ++d0) qr[d0] = *reinterpret_cast<const bf16x8*>(Qw + d0 * 16);
  int kso[NKC];
#pragma unroll
  for (int i = 0; i < NKC; ++i) { const int c = tid + i * 512, row = c / (DQK / 8), cc = c % (DQK / 8); kso[i] = kswz<DQK>(row, cc * 16); }
  const int vst0 = v_st(tid >> 4, (tid & 15) * 8), vst1 = v_st(32 + (tid >> 4), (tid & 15) * 8);
  const int vb0 = (int)(uintptr_t)V_lds + v_rd_base(lane);
  bf16x8 sv0, sv1, sk[NKC];
#define SLOADV(t) do { const bf16* vp_ = Vh + (long)(t) * (64 * 128) + tid * 8; sv0 = *reinterpret_cast<const bf16x8*>(vp_); sv1 = *reinterpret_cast<const bf16x8*>(vp_ + 4096); } while (0)
#define SLOADK(t) do { const bf16* kp_ = Kh + (long)(t) * (64 * DQK) + tid * 8; _Pragma("unroll") for (int q_ = 0; q_ < NKC; ++q_) sk[q_] = *reinterpret_cast<const bf16x8*>(kp_ + q_ * 4096); } while (0)
#define VWRITE(b) do { *reinterpret_cast<bf16x8*>(V_lds + (b) * SHM_V + vst0) = sv0; *reinterpret_cast<bf16x8*>(V_lds + (b) * SHM_V + vst1) = sv1; } while (0)
#define KWRITE(b) do { _Pragma("unroll") for (int q_ = 0; q_ < NKC; ++q_) *reinterpret_cast<bf16x8*>(K_lds + (b) * SHM_K + kso[q_]) = sk[q_]; } while (0)
#define RESC(a) do { if (__any((a) < 1.f)) { if (hi == 0) al_l[r32] = (a); asm volatile("s_waitcnt lgkmcnt(0)" ::: "memory"); \
    _Pragma("unroll") for (int d = 0; d < 4; ++d) _Pragma("unroll") for (int r = 0; r < 16; ++r) o[d][r] *= al_l[crow(r, hi)]; } } while (0)
  f32x16 p0, p1; float mn, al; bf16x8 pa0, pa1, pa2, pa3; const int NTL = seq / 64;
  __syncthreads();
  SLOADK(0); SLOADV(0); asm volatile("s_waitcnt vmcnt(0)" ::: "memory"); KWRITE(0); VWRITE(0);
  __syncthreads();
  SLOADV(1); SLOADK(1);
#define STAGE_SEAM(j) do { if ((j) + 1 < NTL) { VWRITE(knext); KWRITE(knext); } __syncthreads(); \
    if ((j) + 2 < NTL) { SLOADV((j) + 2); SLOADK((j) + 2); } } while (0)
  int kcur = 0, knext = 1;
  bf16x8 pf[4];
  if constexpr (DQK == 64) { kfrag<DQK>(K_lds, 0, r32, hi, pf[0], pf[1]); kfrag<DQK>(K_lds, 1, r32, hi, pf[2], pf[3]); }
#pragma nounroll
  for (int j = 0; j < NTL; ++j) {
    SBAR(); __builtin_amdgcn_s_setprio(1);
    if constexpr (DQK == 64) qkt_pre<DQK>(p0, p1, K_lds + kcur * SHM_K, qr, pf, r32, hi);
    else qkt<DQK, ND0>(p0, p1, K_lds + kcur * SHM_K, qr, nullptr, r32, hi);
    __builtin_amdgcn_s_setprio(0); SBAR();
    if (g == 1) STAGE_SEAM(j);
    s16x4 ta[8]; trk<0>(vb0 + kcur * SHM_V, ta);
    SBAR(); al = softmax_nomax<DQK>(p0, p1, m_reg, l_reg, mzero, j == 0, K_lds + kcur * SHM_K, qr, r32, hi, pa0, pa1, pa2, pa3); RESC(al); SBAR();
    if (g == 0) STAGE_SEAM(j);
    if constexpr (DQK == 64) { if (j + 1 < NTL) { kfrag<DQK>(K_lds + knext * SHM_K, 0, r32, hi, pf[0], pf[1]); kfrag<DQK>(K_lds + knext * SHM_K, 1, r32, hi, pf[2], pf[3]); } }
    SBAR(); __builtin_amdgcn_s_setprio(1); pv_pre(o, vb0 + kcur * SHM_V, ta, pa0, pa1, pa2, pa3); __builtin_amdgcn_s_setprio(0);
    kcur = knext; knext = knext == 2 ? 0 : knext + 1;
  }
#undef STAGE_SEAM
  l_reg = xor32_add(l_reg);
  if (hi == 0) li_l[r32] = l_reg;
  asm volatile("s_waitcnt lgkmcnt(0)" ::: "memory");
  float* Owv = Ow + (wid * 32 + 4 * hi) * 128 + r32;
  asm volatile("" : "+v"(Owv));
#pragma unroll
  for (int r = 0; r < 16; ++r) { const float rl = __builtin_amdgcn_rcpf(li_l[crow(r, hi)]);
#pragma unroll
    for (int d = 0; d < 4; ++d) Owv[crow(r, 0) * 128 + d * 32] = o[d][r] * rl; }
#undef SLOADV
#undef SLOADK
#undef VWRITE
#undef KWRITE
#undef RESC
}

__device__ __forceinline__ void attnA_item(const Params& p, int isS, int pair, int qb, char* lds) {
  const int S = isS ? SS : SP;
  const long rbaseA = (isS ? (long)TP * 8 : 0) + (long)pair * 2 * S, rbaseV = (isS ? (long)TP * 4 : 0) + (long)pair * S;
  const bf16* QA = (const bf16*)((const char*)p.out + OFF_QA); const bf16* KA = (const bf16*)((const char*)p.out + OFF_KA);
  const bf16* VA = (const bf16*)((const char*)p.out + OFF_VA);
  const int tid = threadIdx.x, wid = tid >> 6, lane = tid & 63, r32 = lane & 31, hi = lane >> 5;
  float* scr = reinterpret_cast<float*>(p.ws + OFF_SCR) + (long)blockIdx.x * (2 * 256 * 128);
#pragma nounroll
  for (int map = 0; map < 2; ++map)
    attn_body_stag<64>(QA + (rbaseA + (long)map * S + qb * 256) * 64, KA + (rbaseA + (long)map * S) * 64, VA + rbaseV * 128, S, lds, scr + map * (256 * 128));
  const float lam = *reinterpret_cast<const float*>(p.ws + OFF_LAM);
  const int b = pair >> 2, hd = pair & 3;
  const long tokbase = (isS ? (long)TP : 0) + (long)b * S + qb * 256 + wid * 32;
  const bf16* sag = (const bf16*)((const char*)p.out + OFF_SAG);
  bf16* y = (bf16*)(p.ws + OFF_Y);
  const float* sw = scr + (wid * 32) * 128 + r32;
  float gs[4];
#pragma unroll
  for (int d = 0; d < 4; ++d) gs[d] = p.g_subln[d * 32 + r32] * 0.8f;
#pragma nounroll
  for (int r = 0; r < 16; ++r) {
    const int row = crow(r, hi);
    float v[4], ss = 0;
#pragma unroll
    for (int d = 0; d < 4; ++d) { v[d] = sw[row * 128 + d * 32] - lam * sw[256 * 128 + row * 128 + d * 32]; ss += v[d] * v[d]; }
    ss += __shfl_xor(ss, 1); ss += __shfl_xor(ss, 2); ss += __shfl_xor(ss, 4); ss += __shfl_xor(ss, 8); ss += __shfl_xor(ss, 16);
    const float rs = rsqrtf(ss * (1.f / 128.f) + EPS);
    const long tok = tokbase + row;
#pragma unroll
    for (int d = 0; d < 4; ++d) {
      const int col = hd * 128 + d * 32 + r32;
      const float g = bf2f(*reinterpret_cast<const unsigned short*>(sag + tok * 512 + col));
      y[tok * DM + col] = __float2bfloat16(v[d] * rs * gs[d] * g);
    }
  }
}
__device__ __forceinline__ void attnB_item(const Params& p, int isS, int pair, int qb, char* lds) {
  const int S = isS ? SS : SP;
  const long rbaseV = (isS ? (long)TP * 4 : 0) + (long)pair * S;
  const int tid = threadIdx.x, wid = tid >> 6, lane = tid & 63, r32 = lane & 31, hi = lane >> 5;
  float* scr = reinterpret_cast<float*>(p.ws + OFF_SCR) + (long)blockIdx.x * (2 * 256 * 128);
  attn_body_stag<192>((const bf16*)(p.ws + OFF_QB) + (rbaseV + qb * 256) * 192, (const bf16*)(p.ws + OFF_KB) + rbaseV * 192,
                    (const bf16*)(p.ws + OFF_VB) + rbaseV * 128, S, lds, scr);
  const int b = pair >> 2, hd = pair & 3;
  const long tokbase = (isS ? (long)TP : 0) + (long)b * S + qb * 256 + wid * 32;
  const bf16* sbg = (const bf16*)(p.ws + OFF_SBG);
  bf16* y = (bf16*)(p.ws + OFF_Y);
  const float* sw = scr + (wid * 32) * 128 + r32;
#pragma nounroll
  for (int r = 0; r < 16; ++r) {
    const int row = crow(r, hi);
    const long tok = tokbase + row;
#pragma unroll
    for (int d = 0; d < 4; ++d) {
      const int col = hd * 128 + d * 32 + r32;
      const float g = bf2f(*reinterpret_cast<const unsigned short*>(sbg + tok * 512 + col));
      y[tok * DM + 512 + col] = __float2bfloat16(sw[row * 128 + d * 32] * g);
    }
  }
}

__device__ __forceinline__ void cvt_wT(const float* __restrict__ W, bf16* __restrict__ WT, int K, int N, const float* __restrict__ gain, long gtid, long nthr) {
  const long total = (long)(K / 8) * N;
  for (long idx = gtid; idx < total; idx += nthr) {
    const int k8 = (int)(idx / N), n = (int)(idx - (long)k8 * N);
    float v[8];
#pragma unroll
    for (int i = 0; i < 8; ++i) { v[i] = W[(long)(k8 * 8 + i) * N + n]; if (gain) v[i] *= gain[k8 * 8 + i]; }
    u32x4 w = {cvtpk(v[0], v[1]), cvtpk(v[2], v[3]), cvtpk(v[4], v[5]), cvtpk(v[6], v[7])};
    *reinterpret_cast<u32x4*>(WT + (long)n * K + k8 * 8) = w;
  }
}
__device__ __forceinline__ void phase0(const Params& p, char* lds) {
  const int tid = threadIdx.x;
  const long gtid = (long)blockIdx.x * NTHR + tid, nthr = (long)gridDim.x * NTHR;
  cvt_wT(p.w_in, (bf16*)(p.ws + OFF_WIN), 1024, INC, nullptr, gtid, nthr);
  cvt_wT(p.w_uq, (bf16*)(p.ws + OFF_WUQ), 384, 768, p.g_cq, gtid, nthr);
  cvt_wT(p.w_ukv, (bf16*)(p.ws + OFF_WUKV), 256, 1024, p.g_ckv, gtid, nthr);
  cvt_wT(p.w_out, (bf16*)(p.ws + OFF_WOUT), 1024, 1024, nullptr, gtid, nthr);
  for (long idx = gtid; idx < 16384L * 40; idx += nthr) {
    const int pos = (int)(idx / 40), j = (int)(idx - (long)pos * 40);
    const bool isA = j < 8; const int i = isA ? j : j - 8; const float dim = isA ? 16.f : 64.f;
    const float inv = powf(500000.0f, -(float)(2 * i) / dim);
    const float ang = (float)pos * inv;
    double rev = (double)ang * 0.15915494309189535; rev -= floor(rev);
    const double qd = floor(4.0 * rev + 0.5);
    const double th = (rev - 0.25 * qd) * 6.283185307179586, t2 = th * th;
    const double sn = th * (1.0 + t2 * (-1.0 / 6 + t2 * (1.0 / 120 + t2 * (-1.0 / 5040 + t2 * (1.0 / 362880 + t2 * (-1.0 / 39916800 + t2 * (1.0 / 6227020800.0)))))));
    const double cn = 1.0 + t2 * (-0.5 + t2 * (1.0 / 24 + t2 * (-1.0 / 720 + t2 * (1.0 / 40320 + t2 * (-1.0 / 3628800 + t2 * (1.0 / 479001600.0 + t2 * (-1.0 / 87178291200.0)))))));
    const int qi = ((int)qd) & 3;
    float2 cs;
    cs.x = (float)(qi == 0 ? cn : qi == 1 ? -sn : qi == 2 ? -cn : sn);
    cs.y = (float)(qi == 0 ? sn : qi == 1 ? cn : qi == 2 ? -sn : -cn);
    float2* dst = isA ? reinterpret_cast<float2*>(p.ws + OFF_ROPEA) + (long)pos * 8 + i : reinterpret_cast<float2*>(p.ws + OFF_ROPEB) + (long)pos * 32 + i;
    *dst = cs;
  }
  if (gtid == 0) {
    float d1 = 0, d2 = 0;
    for (int i = 0; i < 64; ++i) { d1 += p.lq1[i] * p.lk1[i]; d2 += p.lq2[i] * p.lk2[i]; }
    *reinterpret_cast<float*>(p.ws + OFF_LAM) = expf(d1) - expf(d2) + 0.2f;
  }
  const int mb = (int)gridDim.x - 1 - (int)blockIdx.x;
  if (mb < 48) {
    float* sc = reinterpret_cast<float*>(lds);
    float* red = sc + 10240;
    for (int i = tid; i < 10240; i += NTHR) { const int b = i >> 10, k = i & 1023; const float v = b < 8 ? p.c_prompt[b * 1024 + k] : p.c_sample[(b - 8) * 1024 + k]; sc[i] = silu_f(v); }
    __syncthreads();
    const int col = tid & 63, kg = tid >> 6;
    float a0 = 0, a1 = 0, a2 = 0, a3 = 0, a4 = 0, a5 = 0, a6 = 0, a7 = 0, a8 = 0, a9 = 0;
#pragma unroll 16
    for (int k = kg * 128; k < kg * 128 + 128; ++k) {
      const float w = p.w_ada[(long)k * 3072 + mb * 64 + col];
      a0 += sc[k] * w; a1 += sc[1024 + k] * w; a2 += sc[2048 + k] * w; a3 += sc[3072 + k] * w; a4 += sc[4096 + k] * w;
      a5 += sc[5120 + k] * w; a6 += sc[6144 + k] * w; a7 += sc[7168 + k] * w; a8 += sc[8192 + k] * w; a9 += sc[9216 + k] * w;
    }
    float* rr = red + kg * 640 + col;
    rr[0] = a0; rr[64] = a1; rr[128] = a2; rr[192] = a3; rr[256] = a4; rr[320] = a5; rr[384] = a6; rr[448] = a7; rr[512] = a8; rr[576] = a9;
    __syncthreads();
    for (int i = tid; i < 640; i += NTHR) {
      float s = 0;
#pragma unroll
      for (int g = 0; g < 8; ++g) s += red[g * 640 + i];
      const int b = i >> 6, c = i & 63;
      reinterpret_cast<float*>(p.ws + OFF_MOD)[b * 3072 + mb * 64 + c] = s + p.b_ada[mb * 64 + c];
    }
    __syncthreads();
  }
}
__device__ __forceinline__ void phase0b(const Params& p) {
  const int tid = threadIdx.x, wid = tid >> 6, lane = tid & 63;
  const float* mod = reinterpret_cast<const float*>(p.ws + OFF_MOD);
  bf16* h = (bf16*)(p.ws + OFF_H);
  const int nw = gridDim.x * 8;
  for (int row0 = blockIdx.x * 8 + wid; row0 < T; row0 += nw * 4) {
    float4 v[4][4];
#pragma unroll
    for (int q = 0; q < 4; ++q) {
      const int row = row0 + q * nw;
      if (row < T) {
        const float* xr = row < TP ? p.x_prompt + (long)row * DM : p.x_sample + (long)(row - TP) * DM;
#pragma unroll
        for (int i = 0; i < 4; ++i) v[q][i] = *reinterpret_cast<const float4*>(xr + i * 256 + lane * 4);
      }
    }
#pragma unroll
    for (int q = 0; q < 4; ++q) {
      const int row = row0 + q * nw;
      if (row < T) {
        const int bm = row < TP ? row >> 13 : 8 + ((row - TP) >> 14);
        float ss = 0;
#pragma unroll
        for (int i = 0; i < 4; ++i) ss += v[q][i].x * v[q][i].x + v[q][i].y * v[q][i].y + v[q][i].z * v[q][i].z + v[q][i].w * v[q][i].w;
#pragma unroll
        for (int m = 1; m < 64; m <<= 1) ss += __shfl_xor(ss, m);
        const float rs = rsqrtf(ss * (1.f / 1024.f) + EPS);
#pragma unroll
        for (int i = 0; i < 4; ++i) {
          const int c = i * 256 + lane * 4;
          const float4 g = *reinterpret_cast<const float4*>(p.g_pre + c);
          const float4 sh = *reinterpret_cast<const float4*>(mod + bm * 3072 + c), sc = *reinterpret_cast<const float4*>(mod + bm * 3072 + 1024 + c);
          st4(h + (long)row * DM + c, v[q][i].x * rs * g.x * (1.f + sc.x) + sh.x, v[q][i].y * rs * g.y * (1.f + sc.y) + sh.y,
              v[q][i].z * rs * g.z * (1.f + sc.z) + sh.z, v[q][i].w * rs * g.w * (1.f + sc.w) + sh.w);
        }
      }
    }
  }
}
__device__ __forceinline__ void phase4(const Params& p) {
  const int tid = threadIdx.x, wid = tid >> 6, lane = tid & 63;
  const float* mod = reinterpret_cast<const float*>(p.ws + OFF_MOD);
  const bf16* ob = (const bf16*)(p.ws + OFF_OUTB);
  const float* sso = reinterpret_cast<const float*>(p.ws + OFF_SSO);
  const int nw = gridDim.x * 8;
  for (int row0 = blockIdx.x * 8 + wid; row0 < T; row0 += nw * 4) {
    float4 x[4][4]; uint2 ou[4][4]; float ssv[4];
#pragma unroll
    for (int q = 0; q < 4; ++q) {
      const int row = row0 + q * nw;
      if (row < T) {
        const float* xr = row < TP ? p.x_prompt + (long)row * DM : p.x_sample + (long)(row - TP) * DM;
        ssv[q] = lane < 32 ? sso[(long)row * 32 + lane] : 0.f;
#pragma unroll
        for (int i = 0; i < 4; ++i) { const int c = i * 256 + lane * 4; { using f32x4 = __attribute__((ext_vector_type(4))) float; const f32x4 xv = __builtin_nontemporal_load(reinterpret_cast<const f32x4*>(xr + c)); x[q][i] = make_float4(xv[0], xv[1], xv[2], xv[3]); } ou[q][i] = *reinterpret_cast<const uint2*>(ob + (long)row * DM + c); }
      }
    }
#pragma unroll
    for (int q = 0; q < 4; ++q) {
      const int row = row0 + q * nw;
      if (row < T) {
        const int bm = row < TP ? row >> 13 : 8 + ((row - TP) >> 14);
        float ss = ssv[q];
#pragma unroll
        for (int m = 1; m < 64; m <<= 1) ss += __shfl_xor(ss, m);
        const float rs = rsqrtf(ss * (1.f / 1024.f) + EPS);
#pragma unroll
        for (int i = 0; i < 4; ++i) {
          const int c = i * 256 + lane * 4;
          const float4 g = *reinterpret_cast<const float4*>(p.g_post + c), gt = *reinterpret_cast<const float4*>(mod + bm * 3072 + 2048 + c);
          float4 r;
          r.x = x[q][i].x + gt.x * (__uint_as_float(ou[q][i].x << 16) * rs * g.x);
          r.y = x[q][i].y + gt.y * (__uint_as_float(ou[q][i].x & 0xffff0000u) * rs * g.y);
          r.z = x[q][i].z + gt.z * (__uint_as_float(ou[q][i].y << 16) * rs * g.z);
          r.w = x[q][i].w + gt.w * (__uint_as_float(ou[q][i].y & 0xffff0000u) * rs * g.w);
          { using f32x4 = __attribute__((ext_vector_type(4))) float; f32x4 rv = {r.x, r.y, r.z, r.w};
            __builtin_nontemporal_store(rv, reinterpret_cast<f32x4*>(p.out + (long)row * DM + c)); }
        }
      }
    }
  }
}

__global__ void __launch_bounds__(NTHR) hymba_fwd(Params p) {
  extern __shared__ __attribute__((aligned(16))) char lds[];
  cg::grid_group grid = cg::this_grid();
  const int G = gridDim.x, bid = blockIdx.x;

#ifndef PM
#define PM 0xff
#endif
  if (PM & 1) phase0(p, lds);
  grid.sync();
  if (PM & 1) phase0b(p);
  grid.sync();
  for (int v = bid; v < 6528 + 255; v += G) {
    const int i = v & 255, k = v >> 8, st = k * 8 + (i & 7), id = st * 32 + (i >> 3);
    if ((PM & 2) && id < 6528) phase1_tile(p, id / 17, id % 17, lds);
  }
  grid.sync();
  if (PM & 4) for (int id = bid; id < 384 * 7; id += G) phase1b_tile(p, id / 7, id % 7, lds);
  grid.sync();
  for (int it = bid; it < 3072; it += G) {
    int cls, j;
    if (it < 512) { cls = 0; j = it; } else if (it < 1024) { cls = 1; j = it - 512; } else if (it < 2048) { cls = 2; j = it - 1024; } else { cls = 3; j = it - 2048; }
    const int i = j & 255, kk = j >> 8, xcd = i & 7, loc = i >> 3;
    const int isS = cls < 2;
    const int pair = isS ? xcd : kk * 8 + xcd, qb = isS ? kk * 32 + loc : loc;
    if (cls == 0 || cls == 2) { if (PM & 8) attnA_item(p, isS, pair, qb, lds); } else { if (PM & 16) attnB_item(p, isS, pair, qb, lds); }
  }
  grid.sync();
  if (PM & 32) for (int id = bid; id < 384 * 4; id += G) phase3_tile(p, id >> 2, id & 3, lds);
  grid.sync();
  if (PM & 64) phase4(p);
}

extern "C" void kernel_launch(void* const* d_in, const int* in_sizes, int n_in, void* d_out, int out_size, void* d_ws, size_t ws_size, hipStream_t stream) {
  static int grid_blocks = 0;
  if (!grid_blocks) {
    int dev = 0, cus = 0, per_cu = 0;
    hipGetDevice(&dev);
    hipDeviceGetAttribute(&cus, hipDeviceAttributeMultiprocessorCount, dev);
    hipFuncSetAttribute((const void*)hymba_fwd, hipFuncAttributeMaxDynamicSharedMemorySize, LDS_BYTES);
    hipOccupancyMaxActiveBlocksPerMultiprocessor(&per_cu, (const void*)hymba_fwd, NTHR, LDS_BYTES);
    if (per_cu < 1) per_cu = 1;
    if (per_cu > 1) per_cu = 1;
    grid_blocks = cus * per_cu;
    if (grid_blocks > 256) grid_blocks = 256;
  }
  Params p{};
  p.x_prompt = (const float*)d_in[0]; p.x_sample = (const float*)d_in[1]; p.c_prompt = (const float*)d_in[2]; p.c_sample = (const float*)d_in[3];
  p.w_ada = (const float*)d_in[4]; p.b_ada = (const float*)d_in[5]; p.g_pre = (const float*)d_in[6]; p.w_in = (const float*)d_in[7];
  p.lq1 = (const float*)d_in[8]; p.lk1 = (const float*)d_in[9]; p.lq2 = (const float*)d_in[10]; p.lk2 = (const float*)d_in[11];
  p.g_subln = (const float*)d_in[12]; p.g_cq = (const float*)d_in[13]; p.w_uq = (const float*)d_in[14]; p.g_ckv = (const float*)d_in[15];
  p.w_ukv = (const float*)d_in[16]; p.w_out = (const float*)d_in[17]; p.g_post = (const float*)d_in[18];
  p.out = (float*)d_out; p.ws = (char*)d_ws;
  void* args[] = {&p};
  hipError_t e = hipLaunchCooperativeKernel((const void*)hymba_fwd, dim3(grid_blocks), dim3(NTHR), args, LDS_BYTES, stream);
  if (e != hipSuccess) fprintf(stderr, "cooperative launch failed: %s (grid %d)\n", hipGetErrorString(e), grid_blocks);
}
```

```cpp
#include <hip/hip_runtime.h>
#include <hip/hip_bf16.h>
#include <hip/hip_cooperative_groups.h>
#include <cstdio>
#include <cstdint>
namespace cg = cooperative_groups;

using bf16 = __hip_bfloat16;
using bf16x8 = __attribute__((ext_vector_type(8))) short;
using s16x4  = __attribute__((ext_vector_type(4))) short;
using f32x16 = __attribute__((ext_vector_type(16))) float;
using u32x4  = __attribute__((ext_vector_type(4))) unsigned;

constexpr int SHM_V_ = 16384;
constexpr int DM = 1024, TP = 65536, TS = 32768, T = TP + TS, SP = 8192, SS = 16384;
constexpr int INC = 3264;
constexpr float EPS = 1e-6f;
constexpr float QSCALE_A = 0.125f * 1.4426950408889634f, QSCALE_B = 0.07216878364870322f * 1.4426950408889634f;
constexpr int NTHR = 512;
constexpr size_t MiB = 1ull << 20;
constexpr size_t OFF_H = 0, OFF_Y = 0, OFF_SBG = 192 * MiB, OFF_CQ = 288 * MiB, OFF_CKV = 360 * MiB, OFF_QB = 408 * MiB, OFF_KB = 552 * MiB,
                 OFF_VB = 696 * MiB, OFF_OUTB = 408 * MiB, OFF_WIN = 792 * MiB, OFF_WUQ = 800 * MiB, OFF_WUKV = 801 * MiB, OFF_WOUT = 802 * MiB,
                 OFF_ROPEA = 804 * MiB, OFF_ROPEB = 805 * MiB, OFF_MOD = 809 * MiB, OFF_LAM = 809 * MiB + 512 * 1024, OFF_SSQ = 810 * MiB,
                 OFF_SSKV = 815 * MiB, OFF_SSO = 818 * MiB, OFF_SCR = 830 * MiB;
constexpr size_t OFF_QA = 0, OFF_KA = 96 * MiB, OFF_VA = 192 * MiB, OFF_SAG = 288 * MiB;
constexpr int LDS_BYTES = 2 * SHM_V_ + 2 * 64 * 192 * 2 + 2048 + 8 * 8192;

struct Params {
  const float *x_prompt, *x_sample, *c_prompt, *c_sample, *w_ada, *b_ada, *g_pre, *w_in, *lq1, *lk1, *lq2, *lk2, *g_subln, *g_cq, *w_uq, *g_ckv,
      *w_ukv, *w_out, *g_post;
  float* out;
  char* ws;
};

#define SBAR() __builtin_amdgcn_sched_barrier(0)
__device__ __forceinline__ int crow(int r, int hi) { return (r & 3) + 8 * (r >> 2) + 4 * hi; }
__device__ __forceinline__ unsigned cvtpk(float lo, float hi) {
  unsigned r; asm volatile("v_cvt_pk_bf16_f32 %0, %1, %2" : "=v"(r) : "v"(lo), "v"(hi)); return r;
}
__device__ __forceinline__ void st4(bf16* p, float a, float b, float c, float d) { uint2 v; v.x = cvtpk(a, b); v.y = cvtpk(c, d); *reinterpret_cast<uint2*>(p) = v; }
__device__ __forceinline__ float silu_f(float v) { return v / (1.f + __expf(-v)); }
__device__ __forceinline__ float bf2f(unsigned short u) { return __uint_as_float(((unsigned)u) << 16); }
__device__ __forceinline__ float xor32_add(float v) {
  auto rr = __builtin_amdgcn_permlane32_swap(__float_as_uint(v), __float_as_uint(v), false, false);
  return __uint_as_float(rr[0]) + __uint_as_float(rr[1]);
}

struct TokInfo { int bmod, bb, S, s0, isS; };
__device__ __forceinline__ TokInfo tokinfo(int t0) {
  TokInfo ti;
  if (t0 < TP) { ti.isS = 0; ti.bb = t0 >> 13; ti.bmod = ti.bb; ti.S = SP; ti.s0 = t0 & (SP - 1); }
  else { int u = t0 - TP; ti.isS = 1; ti.bb = u >> 14; ti.bmod = 8 + ti.bb; ti.S = SS; ti.s0 = u & (SS - 1); }
  return ti;
}
__device__ __forceinline__ long rowV(const TokInfo& ti, int hd, int s) { return (ti.isS ? (long)TP * 4 : 0) + (long)(ti.bb * 4 + hd) * ti.S + s; }
__device__ __forceinline__ long rowA(const TokInfo& ti, int hd, int map, int s) { return (ti.isS ? (long)TP * 8 : 0) + (long)((ti.bb * 4 + hd) * 2 + map) * ti.S + s; }

template <int NT>
__device__ __forceinline__ void gemm_main(const bf16* __restrict__ Ag, const bf16* __restrict__ Bg, const int K, char* lds, f32x16 (&acc)[2][NT]) {
  constexpr int A_BYTES = NT * 64 * 128, STAGE = A_BYTES + 32768;
  int tid_ = threadIdx.x; asm volatile("" : "+v"(tid_));
  const int tid = tid_, lane = tid & 63, wid = tid >> 6, r32 = lane & 31, hi = lane >> 5, tw = wid >> 1, fw = wid & 1;
  const int srow = tid >> 3, scc = tid & 7;
  const int soff = srow * 128 + ((scc ^ ((srow >> 1) & 7)) << 4);
  const bf16* ag = Ag + (long)srow * K + scc * 8;
  const bf16* bg = Bg + (long)srow * K + scc * 8;
  const int key = (r32 >> 1) & 7;
  const int aoff = (fw * 32 * NT + r32) * 128, boff = A_BYTES + (tw * 64 + r32) * 128;
  bf16x8 ra0[NT], rb0[4], ra1[NT], rb1[4];
#pragma unroll
  for (int ti = 0; ti < 2; ++ti)
#pragma unroll
    for (int fi = 0; fi < NT; ++fi) acc[ti][fi] = f32x16{};
  const int KT = K >> 6;
#define GLOAD(RA, RB, kt) do { _Pragma("unroll") for (int i = 0; i < NT; ++i) RA[i] = *reinterpret_cast<const bf16x8*>(ag + (long)i * 64 * K + (kt) * 64); \
    _Pragma("unroll") for (int i = 0; i < 4; ++i) RB[i] = *reinterpret_cast<const bf16x8*>(bg + (long)i * 64 * K + (kt) * 64); } while (0)
#define GWRITE(buf, RA, RB) do { char* b_ = lds + (buf) * STAGE; _Pragma("unroll") for (int i = 0; i < NT; ++i) *reinterpret_cast<bf16x8*>(b_ + i * 8192 + soff) = RA[i]; \
    _Pragma("unroll") for (int i = 0; i < 4; ++i) *reinterpret_cast<bf16x8*>(b_ + A_BYTES + i * 8192 + soff) = RB[i]; } while (0)
#define GCOMP(buf) do { const char* base = lds + (buf) * STAGE; \
    _Pragma("unroll") for (int ks = 0; ks < 4; ++ks) { \
      const int ko = ((ks * 2 + hi) ^ key) << 4; \
      bf16x8 af[NT], bfr[2]; \
      _Pragma("unroll") for (int fi = 0; fi < NT; ++fi) af[fi] = *reinterpret_cast<const bf16x8*>(base + aoff + fi * 4096 + ko); \
      _Pragma("unroll") for (int ti = 0; ti < 2; ++ti) bfr[ti] = *reinterpret_cast<const bf16x8*>(base + boff + ti * 4096 + ko); \
      _Pragma("unroll") for (int ti = 0; ti < 2; ++ti) \
        _Pragma("unroll") for (int fi = 0; fi < NT; ++fi) acc[ti][fi] = __builtin_amdgcn_mfma_f32_32x32x16_bf16(af[fi], bfr[ti], acc[ti][fi], 0, 0, 0); \
    } } while (0)
  GLOAD(ra0, rb0, 0); GLOAD(ra1, rb1, 1);
  __syncthreads();
  GWRITE(0, ra0, rb0);
  __syncthreads();
  for (int kt = 0; kt < KT; kt += 2) {
    if (kt + 2 < KT) GLOAD(ra0, rb0, kt + 2);
    SBAR();
    GCOMP(0);
    GWRITE(1, ra1, rb1);
    __syncthreads();
    if (kt + 3 < KT) GLOAD(ra1, rb1, kt + 3);
    SBAR();
    GCOMP(1);
    if (kt + 2 < KT) GWRITE(0, ra0, rb0);
    __syncthreads();
  }
#undef GCOMP
#undef GLOAD
#undef GWRITE
}

__device__ __forceinline__ void store_tile(bf16* dst, const f32x16& a, int hi) {
#pragma unroll
  for (int g = 0; g < 4; ++g) st4(dst + 8 * g + 4 * hi, a[4 * g], a[4 * g + 1], a[4 * g + 2], a[4 * g + 3]);
}
__device__ __forceinline__ float sumsq16(const f32x16& a) { float s = 0;
#pragma unroll
  for (int r = 0; r < 16; ++r) s += a[r] * a[r];
  return s; }

__device__ __forceinline__ void p1_generic(const Params& p, f32x16& a, int nb, int tok, int s, const TokInfo& ti, int hi) {
  char* outc = (char*)p.out;
  if (nb < 1024) {
    const int isK = nb >= 512, c = nb & 511, hd = c >> 7, map = (c >> 6) & 1, dbase = c & 63;
    if (!isK) {
#pragma unroll
      for (int r = 0; r < 16; ++r) a[r] *= QSCALE_A;
    }
    if (dbase == 0) {
      const float4* rt = reinterpret_cast<const float4*>(p.ws + OFF_ROPEA) + ((long)s * 8 + 4 * hi) / 2;
      const float4 cs0 = rt[0], cs1 = rt[1];
      const float cc[4] = {cs0.x, cs0.z, cs1.x, cs1.z}, sn[4] = {cs0.y, cs0.w, cs1.y, cs1.w};
#pragma unroll
      for (int r = 0; r < 4; ++r) { const float x1 = a[r], x2 = a[r + 4]; a[r] = x1 * cc[r] - x2 * sn[r]; a[r + 4] = x2 * cc[r] + x1 * sn[r]; }
    }
    bf16* dst = (bf16*)(outc + (isK ? OFF_KA : OFF_QA)) + rowA(ti, hd, map, s) * 64 + dbase;
    store_tile(dst, a, hi);
  } else if (nb < 1536) {
    const int c = nb - 1024, hd = c >> 7, col = c & 127;
    store_tile((bf16*)(outc + OFF_VA) + rowV(ti, hd, s) * 128 + col, a, hi);
  } else if (nb < 2048) {
#pragma unroll
    for (int r = 0; r < 16; ++r) a[r] = silu_f(a[r]);
    store_tile((bf16*)(outc + OFF_SAG) + (long)tok * 512 + (nb - 1536), a, hi);
  } else if (nb < 2432) {
    const float ss = xor32_add(sumsq16(a));
    if (hi == 0) reinterpret_cast<float*>(p.ws + OFF_SSQ)[(long)tok * 12 + ((nb - 2048) >> 5)] = ss;
    store_tile((bf16*)(p.ws + OFF_CQ) + (long)tok * 384 + (nb - 2048), a, hi);
  } else if (nb < 2688) {
    const float ss = xor32_add(sumsq16(a));
    if (hi == 0) reinterpret_cast<float*>(p.ws + OFF_SSKV)[(long)tok * 8 + ((nb - 2432) >> 5)] = ss;
    store_tile((bf16*)(p.ws + OFF_CKV) + (long)tok * 256 + (nb - 2432), a, hi);
  } else if (nb >= 2752) {
#pragma unroll
    for (int r = 0; r < 16; ++r) a[r] = silu_f(a[r]);
    store_tile((bf16*)(p.ws + OFF_SBG) + (long)tok * 512 + (nb - 2752), a, hi);
  }
}
__device__ __forceinline__ void rope64(const Params& p, f32x16& a0, f32x16& a1, int s, int hi, float rs) {
#pragma unroll
  for (int g = 0; g < 4; ++g) {
    const float4* rt = reinterpret_cast<const float4*>(p.ws + OFF_ROPEB) + ((long)s * 32 + 8 * g + 4 * hi) / 2;
    const float4 cs0 = rt[0], cs1 = rt[1];
    const float cc[4] = {cs0.x, cs0.z, cs1.x, cs1.z}, sn[4] = {cs0.y, cs0.w, cs1.y, cs1.w};
#pragma unroll
    for (int q = 0; q < 4; ++q) { const int r = 4 * g + q; const float x1 = a0[r] * rs, x2 = a1[r] * rs; a0[r] = x1 * cc[q] - x2 * sn[q]; a1[r] = x2 * cc[q] + x1 * sn[q]; }
  }
}

__device__ __forceinline__ void phase1_tile(const Params& p, int tt, int ft, char* lds) {
  const int n0 = ft * 192, t0 = tt * 256;
  f32x16 acc[2][3];
  gemm_main<3>((const bf16*)(p.ws + OFF_WIN) + (long)n0 * DM, (const bf16*)(p.ws + OFF_H) + (long)t0 * DM, DM, lds, acc);
  const int tid = threadIdx.x, lane = tid & 63, wid = __builtin_amdgcn_readfirstlane(tid >> 6), r32 = lane & 31, hi = lane >> 5, tw = wid >> 1, fw = wid & 1;
  const TokInfo ti = tokinfo(t0);
#pragma unroll
  for (int tq = 0; tq < 2; ++tq) {
    const int tok = t0 + tw * 64 + tq * 32 + r32, s = ti.s0 + tw * 64 + tq * 32 + r32;
    if (n0 == 2688 && fw == 0) {
      rope64(p, acc[tq][0], acc[tq][1], s, hi, 1.f);
#pragma unroll
      for (int hd = 0; hd < 4; ++hd) {
        bf16* dst = (bf16*)(p.ws + OFF_KB) + rowV(ti, hd, s) * 192 + 128;
        store_tile(dst, acc[tq][0], hi); store_tile(dst + 32, acc[tq][1], hi);
      }
      p1_generic(p, acc[tq][2], n0 + 64, tok, s, ti, hi);
    } else {
#pragma unroll
      for (int fi = 0; fi < 3; ++fi) p1_generic(p, acc[tq][fi], n0 + fw * 96 + fi * 32, tok, s, ti, hi);
    }
  }
}

__device__ __forceinline__ void phase1b_tile(const Params& p, int tt, int f, char* lds) {
  const int t0 = tt * 256;
  f32x16 acc[2][4];
  const bool isQ = f < 3;
  const int n0 = (isQ ? f : f - 3) * 256;
  if (isQ) gemm_main<4>((const bf16*)(p.ws + OFF_WUQ) + (long)n0 * 384, (const bf16*)(p.ws + OFF_CQ) + (long)t0 * 384, 384, lds, acc);
  else     gemm_main<4>((const bf16*)(p.ws + OFF_WUKV) + (long)n0 * 256, (const bf16*)(p.ws + OFF_CKV) + (long)t0 * 256, 256, lds, acc);
  int tid_ = threadIdx.x; asm volatile("" : "+v"(tid_));
  const int tid = tid_, lane = tid & 63, wid = __builtin_amdgcn_readfirstlane(tid >> 6), r32 = lane & 31, hi = lane >> 5, tw = wid >> 1, fw = wid & 1;
  const TokInfo ti = tokinfo(t0);
#pragma unroll
  for (int tq = 0; tq < 2; ++tq) {
    const int tok = t0 + tw * 64 + tq * 32 + r32, s = ti.s0 + tw * 64 + tq * 32 + r32;
    float rs;
    if (isQ) { const float4* q4 = reinterpret_cast<const float4*>(p.ws + OFF_SSQ) + (long)tok * 3; const float4 a = q4[0], b = q4[1], c = q4[2];
      rs = rsqrtf((a.x + a.y + a.z + a.w + b.x + b.y + b.z + b.w + c.x + c.y + c.z + c.w) * (1.f / 384.f) + EPS) * QSCALE_B; }
    else { const float4* q4 = reinterpret_cast<const float4*>(p.ws + OFF_SSKV) + (long)tok * 2; const float4 a = q4[0], b = q4[1];
      rs = rsqrtf((a.x + a.y + a.z + a.w + b.x + b.y + b.z + b.w) * (1.f / 256.f) + EPS); }
#pragma unroll
    for (int gi = 0; gi < 2; ++gi) {
      const int nw = n0 + fw * 128 + gi * 64;
      f32x16& a0 = acc[tq][2 * gi]; f32x16& a1 = acc[tq][2 * gi + 1];
      if (isQ) {
        const int hd = nw / 192, c = nw - hd * 192;
        bf16* dst = (bf16*)(p.ws + OFF_QB) + rowV(ti, hd, s) * 192 + c;
        if (c == 128) rope64(p, a0, a1, s, hi, rs);
        else {
#pragma unroll
          for (int r = 0; r < 16; ++r) { a0[r] *= rs; a1[r] *= rs; }
        }
        store_tile(dst, a0, hi); store_tile(dst + 32, a1, hi);
      } else {
        const int hd = nw >> 8, c = nw & 255;
#pragma unroll
        for (int r = 0; r < 16; ++r) { a0[r] *= rs; a1[r] *= rs; }
        bf16* dst = (c < 128) ? (bf16*)(p.ws + OFF_KB) + rowV(ti, hd, s) * 192 + c : (bf16*)(p.ws + OFF_VB) + rowV(ti, hd, s) * 128 + (c - 128);
        store_tile(dst, a0, hi); store_tile(dst + 32, a1, hi);
      }
    }
  }
}

__device__ __forceinline__ void phase3_tile(const Params& p, int tt, int f, char* lds) {
  const int t0 = tt * 256, n0 = f * 256;
  f32x16 acc[2][4];
  gemm_main<4>((const bf16*)(p.ws + OFF_WOUT) + (long)n0 * DM, (const bf16*)(p.ws + OFF_Y) + (long)t0 * DM, DM, lds, acc);
  int tid_ = threadIdx.x; asm volatile("" : "+v"(tid_));
  const int tid = tid_, lane = tid & 63, wid = __builtin_amdgcn_readfirstlane(tid >> 6), r32 = lane & 31, hi = lane >> 5, tw = wid >> 1, fw = wid & 1;
#pragma unroll
  for (int tq = 0; tq < 2; ++tq) {
    const int tok = t0 + tw * 64 + tq * 32 + r32;
#pragma unroll
    for (int fi = 0; fi < 4; ++fi) {
      const int nb = n0 + fw * 128 + fi * 32;
      const float ss = xor32_add(sumsq16(acc[tq][fi]));
      if (hi == 0) reinterpret_cast<float*>(p.ws + OFF_SSO)[(long)tok * 32 + (nb >> 5)] = ss;
      store_tile((bf16*)(p.ws + OFF_OUTB) + (long)tok * DM + nb, acc[tq][fi], hi);
    }
  }
}

constexpr int SHM_V = 64 * 128 * 2;
constexpr float THR = 8.f;
template <int DQK> struct AC {
  static constexpr int KROWB = DQK * 2, SHM_K = 64 * DQK * 2, NKC = DQK / 64, ND0 = DQK / 16;
  static constexpr float SCALE = (DQK == 64) ? 0.125f : 0.07216878364870322f;
};
template <int DQK> __device__ __forceinline__ int kswz(int row, int cb) { return row * (DQK * 2) + (cb ^ (((row >> 1) & 7) << 4)); }

template <int DQK>
__device__ __forceinline__ void partialSM(f32x16& p0, f32x16& p1, float& m_reg, float& mn, float& alpha) {
  constexpr float SCALE = AC<DQK>::SCALE, C = SCALE * 1.4426950408889634f;
  float pmax = p0[0];
#pragma unroll
  for (int r = 1; r < 16; ++r) pmax = fmaxf(pmax, p0[r]);
#pragma unroll
  for (int r = 0; r < 16; ++r) pmax = fmaxf(pmax, p1[r]);
  { auto rr = __builtin_amdgcn_permlane32_swap(__float_as_uint(pmax), __float_as_uint(pmax), false, false);
    pmax = fmaxf(__uint_as_float(rr[0]), __uint_as_float(rr[1])); }
  if (__builtin_expect(__all(pmax - m_reg <= THR / SCALE), 1)) { mn = m_reg; alpha = 1.f; }
  else { mn = fmaxf(m_reg, pmax); alpha = __builtin_amdgcn_exp2f((m_reg - mn) * C); m_reg = mn; }
  const float mnC = -mn * C;
#pragma unroll
  for (int r = 0; r < 16; ++r) p0[r] = fmaf(p0[r], C, mnC);
#pragma unroll
  for (int r = 0; r < 16; ++r) p1[r] = fmaf(p1[r], C, mnC);
#pragma unroll
  for (int r = 0; r < 16; ++r) p0[r] = __builtin_amdgcn_exp2f(p0[r]);
}
__device__ __forceinline__ void finishSM(f32x16& p0, f32x16& p1, float alpha, float& l_reg, bf16x8& pa0, bf16x8& pa1, bf16x8& pa2, bf16x8& pa3) {
#pragma unroll
  for (int r = 0; r < 16; ++r) p1[r] = __builtin_amdgcn_exp2f(p1[r]);
  float ps = 0;
#pragma unroll
  for (int r = 0; r < 16; ++r) ps += p0[r];
#pragma unroll
  for (int r = 0; r < 16; ++r) ps += p1[r];
  ps = xor32_add(ps);
  l_reg = l_reg * alpha + ps;
#define PK4(P, BASE, OUT) do { u32x4 w = {cvtpk(P[BASE + 0], P[BASE + 1]), cvtpk(P[BASE + 2], P[BASE + 3]), cvtpk(P[BASE + 4], P[BASE + 5]), cvtpk(P[BASE + 6], P[BASE + 7])}; \
    OUT = *reinterpret_cast<bf16x8*>(&w); } while (0)
  PK4(p0, 0, pa0); PK4(p0, 8, pa1); PK4(p1, 0, pa2); PK4(p1, 8, pa3);
#undef PK4
}
template <int DQK, int NQR>
__device__ __forceinline__ void qkt(f32x16& p0, f32x16& p1, const char* Ks, const bf16x8* qr, const char* ql, int r32, int hi) {
  p0 = f32x16{}; p1 = f32x16{};
  const int kx = ((r32 >> 1) & 7) << 4, rb = r32 * (DQK * 2);
  const char* kb0 = Ks + rb + ((0 * 32 + hi * 16) ^ kx); const char* kb1 = Ks + rb + ((1 * 32 + hi * 16) ^ kx);
  const char* kb2 = Ks + rb + ((2 * 32 + hi * 16) ^ kx); const char* kb3 = Ks + rb + ((3 * 32 + hi * 16) ^ kx);
  constexpr int ND = DQK / 16, LOOK = 2;
  bf16x8 fa[ND], fb[ND];
#define KLD(d) do { const char* kb_ = (((d) & 3) == 0 ? kb0 : ((d) & 3) == 1 ? kb1 : ((d) & 3) == 2 ? kb2 : kb3) + ((d) >> 2) * 128; \
    fa[d] = *reinterpret_cast<const bf16x8*>(kb_); fb[d] = *reinterpret_cast<const bf16x8*>(kb_ + 32 * (DQK * 2)); } while (0)
#pragma unroll
  for (int d0 = 0; d0 < LOOK && d0 < ND; ++d0) KLD(d0);
#pragma unroll
  for (int d0 = 0; d0 < ND; ++d0) {
    if (d0 + LOOK < ND) KLD(d0 + LOOK);
    bf16x8 q;
    if (d0 < NQR) q = qr[d0]; else q = *reinterpret_cast<const bf16x8*>(ql + (d0 - NQR) * 8192);
    p0 = __builtin_amdgcn_mfma_f32_32x32x16_bf16(fa[d0], q, p0, 0, 0, 0);
    p1 = __builtin_amdgcn_mfma_f32_32x32x16_bf16(fb[d0], q, p1, 0, 0, 0);
    SBAR(); }
#undef KLD
}
template <int DQK>
__device__ __forceinline__ void kfrag(const char* Ks, int d, int r32, int hi, bf16x8& fa, bf16x8& fb) {
  const int kx = ((r32 >> 1) & 7) << 4, rb = r32 * (DQK * 2);
  const char* kb_ = Ks + rb + (((d & 3) * 32 + hi * 16) ^ kx) + (d >> 2) * 128;
  fa = *reinterpret_cast<const bf16x8*>(kb_); fb = *reinterpret_cast<const bf16x8*>(kb_ + 32 * (DQK * 2));
}
template <int DQK>
__device__ __forceinline__ void qkt_pre(f32x16& p0, f32x16& p1, const char* Ks, const bf16x8* qr, const bf16x8 (&pf)[4], int r32, int hi) {
  constexpr int ND = DQK / 16;
  bf16x8 fa[ND], fb[ND];
  fa[0] = pf[0]; fb[0] = pf[1]; fa[1] = pf[2]; fb[1] = pf[3];
  p0 = f32x16{}; p1 = f32x16{};
#pragma unroll
  for (int d0 = 0; d0 < ND; ++d0) {
    if (d0 + 2 < ND) kfrag<DQK>(Ks, d0 + 2, r32, hi, fa[d0 + 2], fb[d0 + 2]);
    p0 = __builtin_amdgcn_mfma_f32_32x32x16_bf16(fa[d0], qr[d0], p0, 0, 0, 0);
    p1 = __builtin_amdgcn_mfma_f32_32x32x16_bf16(fb[d0], qr[d0], p1, 0, 0, 0);
    SBAR(); }
}
__device__ __forceinline__ int v_st(int k, int c) { const int kk = k;   return ((kk >> 3) * 4 + (c >> 5)) * 512 + ((kk & 7) * 32 + (c & 31)) * 2; }
__device__ __forceinline__ int v_rd_base(int lane) { return ((lane & 3) << 3) | (((lane >> 2) & 3) << 6) | (((lane >> 4) & 1) << 5) | (((lane >> 5) & 1) << 8); }
constexpr int v_rd_off(int d0, int ks, int half) { return d0 * 512 + ks * 4096 + half * 2048; }
template <int OFF> __device__ __forceinline__ s16x4 tr_read(int vb) {
  return __builtin_amdgcn_ds_read_tr16_b64_v4i16((__attribute__((address_space(3))) s16x4*)(uintptr_t)(unsigned)(vb + OFF));
}
template <int D0> __device__ __forceinline__ void pv_one(f32x16& od, int vb, bf16x8 pa0, bf16x8 pa1, bf16x8 pa2, bf16x8 pa3) {
  const s16x4 l0 = tr_read<v_rd_off(D0, 0, 0)>(vb), h0 = tr_read<v_rd_off(D0, 0, 1)>(vb), l1 = tr_read<v_rd_off(D0, 1, 0)>(vb), h1 = tr_read<v_rd_off(D0, 1, 1)>(vb);
  const s16x4 l2 = tr_read<v_rd_off(D0, 2, 0)>(vb), h2 = tr_read<v_rd_off(D0, 2, 1)>(vb), l3 = tr_read<v_rd_off(D0, 3, 0)>(vb), h3 = tr_read<v_rd_off(D0, 3, 1)>(vb);
  asm volatile("s_waitcnt lgkmcnt(0)" ::: "memory"); SBAR();
#define PK(L, H) (bf16x8){L[0], L[1], L[2], L[3], H[0], H[1], H[2], H[3]}
  od = __builtin_amdgcn_mfma_f32_32x32x16_bf16(pa0, PK(l0, h0), od, 0, 0, 0);
  od = __builtin_amdgcn_mfma_f32_32x32x16_bf16(pa1, PK(l1, h1), od, 0, 0, 0);
  od = __builtin_amdgcn_mfma_f32_32x32x16_bf16(pa2, PK(l2, h2), od, 0, 0, 0);
  od = __builtin_amdgcn_mfma_f32_32x32x16_bf16(pa3, PK(l3, h3), od, 0, 0, 0);
#undef PK
}
template <int KS> __device__ __forceinline__ void pv_ks(f32x16* o, int vb, bf16x8 pa) {
  const s16x4 l0 = tr_read<v_rd_off(0, KS, 0)>(vb), h0 = tr_read<v_rd_off(0, KS, 1)>(vb), l1 = tr_read<v_rd_off(1, KS, 0)>(vb), h1 = tr_read<v_rd_off(1, KS, 1)>(vb);
  const s16x4 l2 = tr_read<v_rd_off(2, KS, 0)>(vb), h2 = tr_read<v_rd_off(2, KS, 1)>(vb), l3 = tr_read<v_rd_off(3, KS, 0)>(vb), h3 = tr_read<v_rd_off(3, KS, 1)>(vb);
  asm volatile("s_waitcnt lgkmcnt(0)" ::: "memory"); SBAR();
#define PK(L, H) (bf16x8){L[0], L[1], L[2], L[3], H[0], H[1], H[2], H[3]}
  o[0] = __builtin_amdgcn_mfma_f32_32x32x16_bf16(pa, PK(l0, h0), o[0], 0, 0, 0);
  o[1] = __builtin_amdgcn_mfma_f32_32x32x16_bf16(pa, PK(l1, h1), o[1], 0, 0, 0);
  o[2] = __builtin_amdgcn_mfma_f32_32x32x16_bf16(pa, PK(l2, h2), o[2], 0, 0, 0);
  o[3] = __builtin_amdgcn_mfma_f32_32x32x16_bf16(pa, PK(l3, h3), o[3], 0, 0, 0);
#undef PK
}
template <int KS> __device__ __forceinline__ void trk(int vb, s16x4 (&t)[8]) {
  t[0] = tr_read<v_rd_off(0, KS, 0)>(vb); t[1] = tr_read<v_rd_off(0, KS, 1)>(vb); t[2] = tr_read<v_rd_off(1, KS, 0)>(vb); t[3] = tr_read<v_rd_off(1, KS, 1)>(vb);
  t[4] = tr_read<v_rd_off(2, KS, 0)>(vb); t[5] = tr_read<v_rd_off(2, KS, 1)>(vb); t[6] = tr_read<v_rd_off(3, KS, 0)>(vb); t[7] = tr_read<v_rd_off(3, KS, 1)>(vb);
}
__device__ __forceinline__ void mfk(f32x16* o, const s16x4 (&t)[8], bf16x8 pa) {
#define PK(L, H) (bf16x8){L[0], L[1], L[2], L[3], H[0], H[1], H[2], H[3]}
  o[0] = __builtin_amdgcn_mfma_f32_32x32x16_bf16(pa, PK(t[0], t[1]), o[0], 0, 0, 0);
  o[1] = __builtin_amdgcn_mfma_f32_32x32x16_bf16(pa, PK(t[2], t[3]), o[1], 0, 0, 0);
  o[2] = __builtin_amdgcn_mfma_f32_32x32x16_bf16(pa, PK(t[4], t[5]), o[2], 0, 0, 0);
  o[3] = __builtin_amdgcn_mfma_f32_32x32x16_bf16(pa, PK(t[6], t[7]), o[3], 0, 0, 0);
#undef PK
}
__device__ __forceinline__ void pv_pre(f32x16* o, int vb, s16x4 (&ta)[8], bf16x8 pa0, bf16x8 pa1, bf16x8 pa2, bf16x8 pa3) {
  s16x4 tb[8];
  trk<1>(vb, tb); SBAR(); mfk(o, ta, pa0); SBAR();
  trk<2>(vb, ta); SBAR(); mfk(o, tb, pa1); SBAR();
  trk<3>(vb, tb); SBAR(); mfk(o, ta, pa2); SBAR();
  mfk(o, tb, pa3);
}
__device__ __forceinline__ void pv_d0(f32x16* o, int vb, bf16x8 pa0, bf16x8 pa1, bf16x8 pa2, bf16x8 pa3) {
  s16x4 ta[8]; trk<0>(vb, ta); pv_pre(o, vb, ta, pa0, pa1, pa2, pa3);
}

template <int DQK, int SDEPTH, int NQR>
__device__ __forceinline__ void attn_body(const bf16* __restrict__ Qb, const bf16* __restrict__ Kh, const bf16* __restrict__ Vh, int seq, char* lds, float* __restrict__ Ow) {
  constexpr int SHM_K = AC<DQK>::SHM_K, NKC = AC<DQK>::NKC, ND0 = AC<DQK>::ND0, NL = NKC + 2;
  int tid_ = threadIdx.x; asm volatile("" : "+v"(tid_));
  const int tid = tid_, wid = tid >> 6, lane = tid & 63, r32 = lane & 31, hi = lane >> 5;
  char* V_lds = lds; char* K_lds = lds + 2 * SHM_V;
  float* wsf = (float*)(lds + 2 * SHM_V + 2 * SHM_K) + wid * 64; float* li_l = wsf; float* al_l = wsf + 32;
  float m_reg = -1e30f, l_reg = 0; bf16x8 qr[NQR]; f32x16 o[4];
  char* ql = lds + 2 * SHM_V + 2 * SHM_K + 2048 + tid * 16;
#pragma unroll
  for (int d = 0; d < 4; ++d) o[d] = f32x16{};
  const bf16* Qw = Qb + (long)(wid * 32 + r32) * DQK + hi * 8;
#pragma unroll
  for (int d0 = 0; d0 < NQR; ++d0) qr[d0] = *reinterpret_cast<const bf16x8*>(Qw + d0 * 16);
  int kso[NKC];
#pragma unroll
  for (int i = 0; i < NKC; ++i) { const int c = tid + i * 512, row = c / (DQK / 8), cc = c % (DQK / 8); kso[i] = kswz<DQK>(row, cc * 16); }
  const int vst0 = v_st(tid >> 4, (tid & 15) * 8), vst1 = v_st(32 + (tid >> 4), (tid & 15) * 8);
  const int vb0 = (int)(uintptr_t)V_lds + v_rd_base(lane);
  struct { bf16x8 v0, v1, k[NKC]; } sr_[SDEPTH];
#define SLOAD(i, k0) do { const bf16* vp_ = Vh + (long)(k0) * 128 + tid * 8; sr_[i].v0 = *reinterpret_cast<const bf16x8*>(vp_); sr_[i].v1 = *reinterpret_cast<const bf16x8*>(vp_ + 4096); \
    const bf16* kp_ = Kh + (long)(k0) * DQK + tid * 8; _Pragma("unroll") for (int q_ = 0; q_ < NKC; ++q_) sr_[i].k[q_] = *reinterpret_cast<const bf16x8*>(kp_ + q_ * 4096); } while (0)
#define SWRITE(b, i) do { *reinterpret_cast<bf16x8*>(V_lds + (b) * SHM_V + vst0) = sr_[i].v0; *reinterpret_cast<bf16x8*>(V_lds + (b) * SHM_V + vst1) = sr_[i].v1; \
    _Pragma("unroll") for (int q_ = 0; q_ < NKC; ++q_) *reinterpret_cast<bf16x8*>(K_lds + (b) * SHM_K + kso[q_]) = sr_[i].k[q_]; } while (0)
#define SWAIT() do { if constexpr (SDEPTH == 2) { if constexpr (NL == 3) asm volatile("s_waitcnt vmcnt(3)" ::: "memory"); else asm volatile("s_waitcnt vmcnt(5)" ::: "memory"); } \
    else asm volatile("s_waitcnt vmcnt(0)" ::: "memory"); } while (0)
#define RESC(a) do { if (__any((a) < 1.f)) { if (hi == 0) al_l[r32] = (a); asm volatile("s_waitcnt lgkmcnt(0)" ::: "memory"); \
    _Pragma("unroll") for (int d = 0; d < 4; ++d) _Pragma("unroll") for (int r = 0; r < 16; ++r) o[d][r] *= al_l[crow(r, hi)]; } } while (0)
  f32x16 pA0, pA1, pB0, pB1; float mnA, mnB, alA, alB; bf16x8 pa0, pa1, pa2, pa3; const int NTL = seq / 64;
  constexpr int SE = 0, SO = SDEPTH - 1;
  __syncthreads();
#pragma unroll
  for (int d0 = NQR; d0 < ND0; ++d0) *reinterpret_cast<bf16x8*>(ql + (d0 - NQR) * 8192) = *reinterpret_cast<const bf16x8*>(Qw + d0 * 16);
  SLOAD(SE, 0); asm volatile("s_waitcnt vmcnt(0)" ::: "memory"); SWRITE(0, SE); __syncthreads();
  qkt<DQK, NQR>(pA0, pA1, K_lds, qr, ql, r32, hi); partialSM<DQK>(pA0, pA1, m_reg, mnA, alA);
  SLOAD(SO, 64); if constexpr (SDEPTH == 2) { if (2 < NTL) SLOAD(SE, 128); }
  SWAIT(); SWRITE(1, SO); __syncthreads();
  for (int j = 1; j + 1 < NTL; j += 2) {
    SBAR(); qkt<DQK, NQR>(pB0, pB1, K_lds + SHM_K, qr, ql, r32, hi);
    finishSM(pA0, pA1, alA, l_reg, pa0, pa1, pa2, pa3); SBAR();
    SLOAD(SO, (j + SDEPTH) * 64); SBAR();
    pv_d0(o, vb0, pa0, pa1, pa2, pa3); partialSM<DQK>(pB0, pB1, m_reg, mnB, alB);
    __syncthreads(); SWAIT(); SWRITE(0, SE);
    RESC(alB); __syncthreads();
    SBAR(); qkt<DQK, NQR>(pA0, pA1, K_lds, qr, ql, r32, hi);
    finishSM(pB0, pB1, alB, l_reg, pa0, pa1, pa2, pa3); SBAR();
    if (SDEPTH == 1 || j + 3 < NTL) SLOAD(SE, (j + 1 + SDEPTH) * 64); SBAR();
    pv_d0(o, vb0 + SHM_V, pa0, pa1, pa2, pa3); partialSM<DQK>(pA0, pA1, m_reg, mnA, alA);
    __syncthreads(); SWAIT(); SWRITE(1, SO);
    RESC(alA); __syncthreads();
  }
  SBAR(); qkt<DQK, NQR>(pB0, pB1, K_lds + SHM_K, qr, ql, r32, hi);
  finishSM(pA0, pA1, alA, l_reg, pa0, pa1, pa2, pa3); SBAR();
  pv_d0(o, vb0, pa0, pa1, pa2, pa3); partialSM<DQK>(pB0, pB1, m_reg, mnB, alB);
  __syncthreads(); RESC(alB);
  finishSM(pB0, pB1, alB, l_reg, pa0, pa1, pa2, pa3); SBAR();
  pv_d0(o, vb0 + SHM_V, pa0, pa1, pa2, pa3);
  if (hi == 0) li_l[r32] = l_reg;
  asm volatile("s_waitcnt lgkmcnt(0)" ::: "memory");
  float* Owv = Ow + (wid * 32 + 4 * hi) * 128 + r32;
  asm volatile("" : "+v"(Owv));
#pragma unroll
  for (int r = 0; r < 16; ++r) { const float rl = __builtin_amdgcn_rcpf(li_l[crow(r, hi)]);
#pragma unroll
    for (int d = 0; d < 4; ++d) Owv[crow(r, 0) * 128 + d * 32] = o[d][r] * rl; }
#undef SLOAD
#undef SWRITE
#undef SWAIT
#undef RESC
}

template <int DQK, int NQR>
__device__ __forceinline__ void attn_body_simple(const bf16* __restrict__ Qb, const bf16* __restrict__ Kh, const bf16* __restrict__ Vh, int seq, char* lds, float* __restrict__ Ow) {
  constexpr int SHM_K = AC<DQK>::SHM_K, NKC = AC<DQK>::NKC, ND0 = AC<DQK>::ND0;
  int tid_ = threadIdx.x; asm volatile("" : "+v"(tid_));
  const int tid = tid_, wid = tid >> 6, lane = tid & 63, r32 = lane & 31, hi = lane >> 5;
  char* V_lds = lds; char* K_lds = lds + 2 * SHM_V;
  float* wsf = (float*)(lds + 2 * SHM_V + 2 * SHM_K) + wid * 64; float* li_l = wsf; float* al_l = wsf + 32;
  float m_reg = -1e30f, l_reg = 0; bf16x8 qr[NQR]; f32x16 o[4];
  char* ql = lds + 2 * SHM_V + 2 * SHM_K + 2048 + tid * 16;
#pragma unroll
  for (int d = 0; d < 4; ++d) o[d] = f32x16{};
  const bf16* Qw = Qb + (long)(wid * 32 + r32) * DQK + hi * 8;
#pragma unroll
  for (int d0 = 0; d0 < NQR; ++d0) qr[d0] = *reinterpret_cast<const bf16x8*>(Qw + d0 * 16);
  int kso[NKC];
#pragma unroll
  for (int i = 0; i < NKC; ++i) { const int c = tid + i * 512, row = c / (DQK / 8), cc = c % (DQK / 8); kso[i] = kswz<DQK>(row, cc * 16); }
  const int vst0 = v_st(tid >> 4, (tid & 15) * 8), vst1 = v_st(32 + (tid >> 4), (tid & 15) * 8);
  const int vb0 = (int)(uintptr_t)V_lds + v_rd_base(lane);
  bf16x8 sv0, sv1, sk[NKC];
#define SLOAD(k0) do { const bf16* vp_ = Vh + (long)(k0) * 128 + tid * 8; sv0 = *reinterpret_cast<const bf16x8*>(vp_); sv1 = *reinterpret_cast<const bf16x8*>(vp_ + 4096); \
    const bf16* kp_ = Kh + (long)(k0) * DQK + tid * 8; _Pragma("unroll") for (int q_ = 0; q_ < NKC; ++q_) sk[q_] = *reinterpret_cast<const bf16x8*>(kp_ + q_ * 4096); } while (0)
#define SWRITE(b) do { *reinterpret_cast<bf16x8*>(V_lds + (b) * SHM_V + vst0) = sv0; *reinterpret_cast<bf16x8*>(V_lds + (b) * SHM_V + vst1) = sv1; \
    _Pragma("unroll") for (int q_ = 0; q_ < NKC; ++q_) *reinterpret_cast<bf16x8*>(K_lds + (b) * SHM_K + kso[q_]) = sk[q_]; } while (0)
#define RESC(a) do { if (__any((a) < 1.f)) { if (hi == 0) al_l[r32] = (a); asm volatile("s_waitcnt lgkmcnt(0)" ::: "memory"); \
    _Pragma("unroll") for (int d = 0; d < 4; ++d) _Pragma("unroll") for (int r = 0; r < 16; ++r) o[d][r] *= al_l[crow(r, hi)]; } } while (0)
  f32x16 p0, p1; float mn, al; bf16x8 pa0, pa1, pa2, pa3; const int NTL = seq / 64;
  __syncthreads();
#pragma unroll
  for (int d0 = NQR; d0 < ND0; ++d0) *reinterpret_cast<bf16x8*>(ql + (d0 - NQR) * 8192) = *reinterpret_cast<const bf16x8*>(Qw + d0 * 16);
  SLOAD(0); asm volatile("s_waitcnt vmcnt(0)" ::: "memory"); SWRITE(0); __syncthreads();
#pragma nounroll
  for (int j = 0; j < NTL; ++j) {
    const int b = j & 1;
    if (j + 1 < NTL) SLOAD((j + 1) * 64);
    SBAR(); qkt<DQK, NQR>(p0, p1, K_lds + b * SHM_K, qr, ql, r32, hi);
    partialSM<DQK>(p0, p1, m_reg, mn, al);
    RESC(al);
    finishSM(p0, p1, al, l_reg, pa0, pa1, pa2, pa3); SBAR();
    pv_d0(o, vb0 + b * SHM_V, pa0, pa1, pa2, pa3);
    if (j + 1 < NTL) SWRITE(b ^ 1);
    __syncthreads();
  }
  if (hi == 0) li_l[r32] = l_reg;
  asm volatile("s_waitcnt lgkmcnt(0)" ::: "memory");
  float* Owv = Ow + (wid * 32 + 4 * hi) * 128 + r32;
  asm volatile("" : "+v"(Owv));
#pragma unroll
  for (int r = 0; r < 16; ++r) { const float rl = __builtin_amdgcn_rcpf(li_l[crow(r, hi)]);
#pragma unroll
    for (int d = 0; d < 4; ++d) Owv[crow(r, 0) * 128 + d * 32] = o[d][r] * rl; }
#undef SLOAD
#undef SWRITE
#undef RESC
}

template <int D0> __device__ __forceinline__ void tr8(int vb, s16x4 (&t)[8]) {
  t[0] = tr_read<v_rd_off(D0, 0, 0)>(vb); t[1] = tr_read<v_rd_off(D0, 0, 1)>(vb); t[2] = tr_read<v_rd_off(D0, 1, 0)>(vb); t[3] = tr_read<v_rd_off(D0, 1, 1)>(vb);
  t[4] = tr_read<v_rd_off(D0, 2, 0)>(vb); t[5] = tr_read<v_rd_off(D0, 2, 1)>(vb); t[6] = tr_read<v_rd_off(D0, 3, 0)>(vb); t[7] = tr_read<v_rd_off(D0, 3, 1)>(vb);
}
__device__ __forceinline__ void mf4(f32x16& od, const s16x4 (&t)[8], bf16x8 pa0, bf16x8 pa1, bf16x8 pa2, bf16x8 pa3) {
#define PK(L, H) (bf16x8){L[0], L[1], L[2], L[3], H[0], H[1], H[2], H[3]}
  od = __builtin_amdgcn_mfma_f32_32x32x16_bf16(pa0, PK(t[0], t[1]), od, 0, 0, 0);
  od = __builtin_amdgcn_mfma_f32_32x32x16_bf16(pa1, PK(t[2], t[3]), od, 0, 0, 0);
  od = __builtin_amdgcn_mfma_f32_32x32x16_bf16(pa2, PK(t[4], t[5]), od, 0, 0, 0);
  od = __builtin_amdgcn_mfma_f32_32x32x16_bf16(pa3, PK(t[6], t[7]), od, 0, 0, 0);
#undef PK
}
__device__ __forceinline__ void pv_pipe(f32x16* o, int vb, bf16x8 pa0, bf16x8 pa1, bf16x8 pa2, bf16x8 pa3) {
  s16x4 ta[8], tb[8];
  tr8<0>(vb, ta);
  tr8<1>(vb, tb); asm volatile("s_waitcnt lgkmcnt(8)" ::: "memory"); SBAR(); mf4(o[0], ta, pa0, pa1, pa2, pa3); SBAR();
  tr8<2>(vb, ta); asm volatile("s_waitcnt lgkmcnt(8)" ::: "memory"); SBAR(); mf4(o[1], tb, pa0, pa1, pa2, pa3); SBAR();
  tr8<3>(vb, tb); asm volatile("s_waitcnt lgkmcnt(8)" ::: "memory"); SBAR(); mf4(o[2], ta, pa0, pa1, pa2, pa3); SBAR();
  asm volatile("s_waitcnt lgkmcnt(0)" ::: "memory"); SBAR(); mf4(o[3], tb, pa0, pa1, pa2, pa3);
}
constexpr float BIGSUM = 16384.f, BIG0 = 1.0995116e12f  , TINY0 = 9.094947e-13f  ;
template <int DQK>
__device__ __forceinline__ float softmax_nomax(f32x16& p0, f32x16& p1, float& m_reg, float& l_reg, bool& mzero, bool first, const char* Ks, const bf16x8* qr, int r32, int hi,
                                               bf16x8& pa0, bf16x8& pa1, bf16x8& pa2, bf16x8& pa3) {
  float alpha = 1.f, ps = 0.f; bool ok;
  if (mzero) {
#pragma unroll
    for (int r = 0; r < 16; ++r) { p0[r] = __builtin_amdgcn_exp2f(p0[r]); p1[r] = __builtin_amdgcn_exp2f(p1[r]); }
#pragma unroll
    for (int r = 0; r < 16; ++r) ps += p0[r];
#pragma unroll
    for (int r = 0; r < 16; ++r) ps += p1[r];
    ok = __all(ps <= BIG0 && (!first || ps >= TINY0));
  } else {
#pragma unroll
    for (int r = 0; r < 16; ++r) { p0[r] = __builtin_amdgcn_exp2f(p0[r] - m_reg); p1[r] = __builtin_amdgcn_exp2f(p1[r] - m_reg); }
#pragma unroll
    for (int r = 0; r < 16; ++r) ps += p0[r];
#pragma unroll
    for (int r = 0; r < 16; ++r) ps += p1[r];
    ok = __all(ps <= BIGSUM);
  }
  if (__builtin_expect(!ok, 0)) {
    qkt<DQK, DQK / 16>(p0, p1, Ks, qr, nullptr, r32, hi);
    float pmax = p0[0];
#pragma unroll
    for (int r = 1; r < 16; ++r) pmax = fmaxf(pmax, p0[r]);
#pragma unroll
    for (int r = 0; r < 16; ++r) pmax = fmaxf(pmax, p1[r]);
    { auto rr = __builtin_amdgcn_permlane32_swap(__float_as_uint(pmax), __float_as_uint(pmax), false, false);
      pmax = fmaxf(__uint_as_float(rr[0]), __uint_as_float(rr[1])); }
    const float mn = first ? pmax : fmaxf(m_reg, pmax);
    alpha = first ? 1.f : __builtin_amdgcn_exp2f(m_reg - mn); m_reg = mn; mzero = false;
    ps = 0.f;
#pragma unroll
    for (int r = 0; r < 16; ++r) { p0[r] = __builtin_amdgcn_exp2f(p0[r] - mn); p1[r] = __builtin_amdgcn_exp2f(p1[r] - mn); }
#pragma unroll
    for (int r = 0; r < 16; ++r) ps += p0[r] + p1[r];
  }
  l_reg = l_reg * alpha + ps;
#define PK4(P, BASE, OUT) do { u32x4 w = {cvtpk(P[BASE + 0], P[BASE + 1]), cvtpk(P[BASE + 2], P[BASE + 3]), cvtpk(P[BASE + 4], P[BASE + 5]), cvtpk(P[BASE + 6], P[BASE + 7])}; \
    OUT = *reinterpret_cast<bf16x8*>(&w); } while (0)
  PK4(p0, 0, pa0); PK4(p0, 8, pa1); PK4(p1, 0, pa2); PK4(p1, 8, pa3);
#undef PK4
  return alpha;
}
template <int DQK>
__device__ __forceinline__ void attn_body_stag(const bf16* __restrict__ Qb, const bf16* __restrict__ Kh, const bf16* __restrict__ Vh, int seq, char* lds, float* __restrict__ Ow) {
  constexpr int SHM_K = AC<DQK>::SHM_K, NKC = AC<DQK>::NKC, ND0 = AC<DQK>::ND0;
  int tid_ = threadIdx.x; asm volatile("" : "+v"(tid_));
  const int tid = tid_, wid = tid >> 6, lane = tid & 63, r32 = lane & 31, hi = lane >> 5;
  const int g = __builtin_amdgcn_readfirstlane(wid >> 2);
  char* V_lds = lds; char* K_lds = lds + 3 * SHM_V;
  float* wsf = (float*)(lds + 3 * SHM_V + 3 * SHM_K) + wid * 64; float* li_l = wsf; float* al_l = wsf + 32;
  float m_reg = 0.f, l_reg = 0; bool mzero = true; bf16x8 qr[ND0]; f32x16 o[4];
#pragma unroll
  for (int d = 0; d < 4; ++d) o[d] = f32x16{};
  const bf16* Qw = Qb + (long)(wid * 32 + r32) * DQK + hi * 8;
#pragma unroll
  for (int d0 = 0; d0 < ND0; ++d0) qr[d0] = *reinterpret_cast<const bf16x8*>(Qw + d0 * 16);
  int kso[NKC];
#pragma unroll
  for (int i = 0; i < NKC; ++i) { const int c = tid + i * 512, row = c / (DQK / 8), cc = c % (DQK / 8); kso[i] = kswz<DQK>(row, cc * 16); }
  const int vst0 = v_st(tid >> 4, (tid & 15) * 8), vst1 = v_st(32 + (tid >> 4), (tid & 15) * 8);
  const int vb0 = (int)(uintptr_t)V_lds + v_rd_base(lane);
  bf16x8 sv0, sv1, sk[NKC];
#define SLOADV(t) do { const bf16* vp_ = Vh + (long)(t) * (64 * 128) + tid * 8; sv0 = *reinterpret_cast<const bf16x8*>(vp_); sv1 = *reinterpret_cast<const bf16x8*>(vp_ + 4096); } while (0)
#define SLOADK(t) do { const bf16* kp_ = Kh + (long)(t) * (64 * DQK) + tid * 8; _Pragma("unroll") for (int q_ = 0; q_ < NKC; ++q_) sk[q_] = *reinterpret_cast<const bf16x8*>(kp_ + q_ * 4096); } while (0)
#define VWRITE(b) do { *reinterpret_cast<bf16x8*>(V_lds + (b) * SHM_V + vst0) = sv0; *reinterpret_cast<bf16x8*>(V_lds + (b) * SHM_V + vst1) = sv1; } while (0)
#define KWRITE(b) do { _Pragma("unroll") for (int q_ = 0; q_ < NKC; ++q_) *reinterpret_cast<bf16x8*>(K_lds + (b) * SHM_K + kso[q_]) = sk[q_]; } while (0)
#define RESC(a) do { if (__any((a) < 1.f)) { if (hi == 0) al_l[r32] = (a); asm volatile("s_waitcnt lgkmcnt(0)" ::: "memory"); \
    _Pragma("unroll") for (int d = 0; d < 4; ++d) _Pragma("unroll") for (int r = 0; r < 16; ++r) o[d][r] *= al_l[crow(r, hi)]; } } while (0)
  f32x16 p0, p1; float mn, al; bf16x8 pa0, pa1, pa2, pa3; const int NTL = seq / 64;
  __syncthreads();
  SLOADK(0); SLOADV(0); asm volatile("s_waitcnt vmcnt(0)" ::: "memory"); KWRITE(0); VWRITE(0);
  __syncthreads();
  SLOADV(1); SLOADK(1);
#define STAGE_SEAM(j, knext) do { if ((j) + 1 < NTL) { VWRITE(knext); KWRITE(knext); } __syncthreads(); \
    if ((j) + 2 < NTL) { SLOADV((j) + 2); SLOADK((j) + 2); } } while (0)
  bf16x8 pf[4];
  if constexpr (DQK == 64) { kfrag<DQK>(K_lds, 0, r32, hi, pf[0], pf[1]); kfrag<DQK>(K_lds, 1, r32, hi, pf[2], pf[3]); }
#define TILE_BODY(j, kcur, knext) do { \
    SBAR(); __builtin_amdgcn_s_setprio(1); \
    if constexpr (DQK == 64) qkt_pre<DQK>(p0, p1, K_lds + (kcur) * SHM_K, qr, pf, r32, hi); \
    else qkt<DQK, ND0>(p0, p1, K_lds + (kcur) * SHM_K, qr, nullptr, r32, hi); \
    __builtin_amdgcn_s_setprio(0); SBAR(); \
    if (g == 1) STAGE_SEAM(j, knext); \
    s16x4 ta[8]; trk<0>(vb0 + (kcur) * SHM_V, ta); \
    SBAR(); al = softmax_nomax<DQK>(p0, p1, m_reg, l_reg, mzero, (j) == 0, K_lds + (kcur) * SHM_K, qr, r32, hi, pa0, pa1, pa2, pa3); RESC(al); SBAR(); \
    if (g == 0) STAGE_SEAM(j, knext); \
    if constexpr (DQK == 64) { if ((j) + 1 < NTL) { kfrag<DQK>(K_lds + (knext) * SHM_K, 0, r32, hi, pf[0], pf[1]); kfrag<DQK>(K_lds + (knext) * SHM_K, 1, r32, hi, pf[2], pf[3]); } } \
    SBAR(); __builtin_amdgcn_s_setprio(1); pv_pre(o, vb0 + (kcur) * SHM_V, ta, pa0, pa1, pa2, pa3); __builtin_amdgcn_s_setprio(0); } while (0)
#pragma nounroll
  for (int j = 0; j < NTL; j += 3) {
    TILE_BODY(j, 0, 1);
    if (j + 1 < NTL) TILE_BODY(j + 1, 1, 2);
    if (j + 2 < NTL) TILE_BODY(j + 2, 2, 0);
  }
#undef TILE_BODY
#undef STAGE_SEAM
  l_reg = xor32_add(l_reg);
  if (hi == 0) li_l[r32] = l_reg;
  asm volatile("s_waitcnt lgkmcnt(0)" ::: "memory");
  float* Owv = Ow + (wid * 32 + 4 * hi) * 128 + r32;
  asm volatile("" : "+v"(Owv));
#pragma unroll
  for (int r = 0; r < 16; ++r) { const float rl = __builtin_amdgcn_rcpf(li_l[crow(r, hi)]);
#pragma unroll
    for (int d = 0; d < 4; ++d) Owv[crow(r, 0) * 128 + d * 32] = o[d][r] * rl; }
#undef SLOADV
#undef SLOADK
#undef VWRITE
#undef KWRITE
#undef RESC
}

__device__ __forceinline__ void attnA_item(const Params& p, int isS, int pair, int qb, char* lds) {
  const int S = isS ? SS : SP;
  const long rbaseA = (isS ? (long)TP * 8 : 0) + (long)pair * 2 * S, rbaseV = (isS ? (long)TP * 4 : 0) + (long)pair * S;
  const bf16* QA = (const bf16*)((const char*)p.out + OFF_QA); const bf16* KA = (const bf16*)((const char*)p.out + OFF_KA);
  const bf16* VA = (const bf16*)((const char*)p.out + OFF_VA);
  const int tid = threadIdx.x, wid = tid >> 6, lane = tid & 63, r32 = lane & 31, hi = lane >> 5;
  float* scr = reinterpret_cast<float*>(p.ws + OFF_SCR) + (long)blockIdx.x * (2 * 256 * 128);
#pragma nounroll
  for (int map = 0; map < 2; ++map)
    attn_body_stag<64>(QA + (rbaseA + (long)map * S + qb * 256) * 64, KA + (rbaseA + (long)map * S) * 64, VA + rbaseV * 128, S, lds, scr + map * (256 * 128));
  const float lam = *reinterpret_cast<const float*>(p.ws + OFF_LAM);
  const int b = pair >> 2, hd = pair & 3;
  const long tokbase = (isS ? (long)TP : 0) + (long)b * S + qb * 256 + wid * 32;
  const bf16* sag = (const bf16*)((const char*)p.out + OFF_SAG);
  bf16* y = (bf16*)(p.ws + OFF_Y);
  const float* sw = scr + (wid * 32) * 128 + r32;
  float gs[4];
#pragma unroll
  for (int d = 0; d < 4; ++d) gs[d] = p.g_subln[d * 32 + r32] * 0.8f;
#pragma nounroll
  for (int r = 0; r < 16; ++r) {
    const int row = crow(r, hi);
    float v[4], ss = 0;
#pragma unroll
    for (int d = 0; d < 4; ++d) { v[d] = sw[row * 128 + d * 32] - lam * sw[256 * 128 + row * 128 + d * 32]; ss += v[d] * v[d]; }
    ss += __shfl_xor(ss, 1); ss += __shfl_xor(ss, 2); ss += __shfl_xor(ss, 4); ss += __shfl_xor(ss, 8); ss += __shfl_xor(ss, 16);
    const float rs = rsqrtf(ss * (1.f / 128.f) + EPS);
    const long tok = tokbase + row;
#pragma unroll
    for (int d = 0; d < 4; ++d) {
      const int col = hd * 128 + d * 32 + r32;
      const float g = bf2f(*reinterpret_cast<const unsigned short*>(sag + tok * 512 + col));
      y[tok * DM + col] = __float2bfloat16(v[d] * rs * gs[d] * g);
    }
  }
}
__device__ __forceinline__ void attnB_item(const Params& p, int isS, int pair, int qb, char* lds) {
  const int S = isS ? SS : SP;
  const long rbaseV = (isS ? (long)TP * 4 : 0) + (long)pair * S;
  const int tid = threadIdx.x, wid = tid >> 6, lane = tid & 63, r32 = lane & 31, hi = lane >> 5;
  float* scr = reinterpret_cast<float*>(p.ws + OFF_SCR) + (long)blockIdx.x * (2 * 256 * 128);
  attn_body_stag<192>((const bf16*)(p.ws + OFF_QB) + (rbaseV + qb * 256) * 192, (const bf16*)(p.ws + OFF_KB) + rbaseV * 192,
                    (const bf16*)(p.ws + OFF_VB) + rbaseV * 128, S, lds, scr);
  const int b = pair >> 2, hd = pair & 3;
  const long tokbase = (isS ? (long)TP : 0) + (long)b * S + qb * 256 + wid * 32;
  const bf16* sbg = (const bf16*)(p.ws + OFF_SBG);
  bf16* y = (bf16*)(p.ws + OFF_Y);
  const float* sw = scr + (wid * 32) * 128 + r32;
#pragma nounroll
  for (int r = 0; r < 16; ++r) {
    const int row = crow(r, hi);
    const long tok = tokbase + row;
#pragma unroll
    for (int d = 0; d < 4; ++d) {
      const int col = hd * 128 + d * 32 + r32;
      const float g = bf2f(*reinterpret_cast<const unsigned short*>(sbg + tok * 512 + col));
      y[tok * DM + 512 + col] = __float2bfloat16(sw[row * 128 + d * 32] * g);
    }
  }
}

__device__ __forceinline__ void cvt_wT(const float* __restrict__ W, bf16* __restrict__ WT, int K, int N, const float* __restrict__ gain, long gtid, long nthr) {
  const long total = (long)(K / 8) * N;
  for (long idx = gtid; idx < total; idx += nthr) {
    const int k8 = (int)(idx / N), n = (int)(idx - (long)k8 * N);
    float v[8];
#pragma unroll
    for (int i = 0; i < 8; ++i) { v[i] = W[(long)(k8 * 8 + i) * N + n]; if (gain) v[i] *= gain[k8 * 8 + i]; }
    u32x4 w = {cvtpk(v[0], v[1]), cvtpk(v[2], v[3]), cvtpk(v[4], v[5]), cvtpk(v[6], v[7])};
    *reinterpret_cast<u32x4*>(WT + (long)n * K + k8 * 8) = w;
  }
}
__device__ __forceinline__ void phase0(const Params& p, char* lds) {
  const int tid = threadIdx.x;
  const long gtid = (long)blockIdx.x * NTHR + tid, nthr = (long)gridDim.x * NTHR;
  cvt_wT(p.w_in, (bf16*)(p.ws + OFF_WIN), 1024, INC, nullptr, gtid, nthr);
  cvt_wT(p.w_uq, (bf16*)(p.ws + OFF_WUQ), 384, 768, p.g_cq, gtid, nthr);
  cvt_wT(p.w_ukv, (bf16*)(p.ws + OFF_WUKV), 256, 1024, p.g_ckv, gtid, nthr);
  cvt_wT(p.w_out, (bf16*)(p.ws + OFF_WOUT), 1024, 1024, nullptr, gtid, nthr);
  for (long idx = gtid; idx < 16384L * 40; idx += nthr) {
    const int pos = (int)(idx / 40), j = (int)(idx - (long)pos * 40);
    const bool isA = j < 8; const int i = isA ? j : j - 8; const float dim = isA ? 16.f : 64.f;
    const float inv = powf(500000.0f, -(float)(2 * i) / dim);
    const float ang = (float)pos * inv;
    double rev = (double)ang * 0.15915494309189535; rev -= floor(rev);
    const double qd = floor(4.0 * rev + 0.5);
    const double th = (rev - 0.25 * qd) * 6.283185307179586, t2 = th * th;
    const double sn = th * (1.0 + t2 * (-1.0 / 6 + t2 * (1.0 / 120 + t2 * (-1.0 / 5040 + t2 * (1.0 / 362880 + t2 * (-1.0 / 39916800 + t2 * (1.0 / 6227020800.0)))))));
    const double cn = 1.0 + t2 * (-0.5 + t2 * (1.0 / 24 + t2 * (-1.0 / 720 + t2 * (1.0 / 40320 + t2 * (-1.0 / 3628800 + t2 * (1.0 / 479001600.0 + t2 * (-1.0 / 87178291200.0)))))));
    const int qi = ((int)qd) & 3;
    float2 cs;
    cs.x = (float)(qi == 0 ? cn : qi == 1 ? -sn : qi == 2 ? -cn : sn);
    cs.y = (float)(qi == 0 ? sn : qi == 1 ? cn : qi == 2 ? -sn : -cn);
    float2* dst = isA ? reinterpret_cast<float2*>(p.ws + OFF_ROPEA) + (long)pos * 8 + i : reinterpret_cast<float2*>(p.ws + OFF_ROPEB) + (long)pos * 32 + i;
    *dst = cs;
  }
  if (gtid == 0) {
    float d1 = 0, d2 = 0;
    for (int i = 0; i < 64; ++i) { d1 += p.lq1[i] * p.lk1[i]; d2 += p.lq2[i] * p.lk2[i]; }
    *reinterpret_cast<float*>(p.ws + OFF_LAM) = expf(d1) - expf(d2) + 0.2f;
  }
  const int mb = (int)gridDim.x - 1 - (int)blockIdx.x;
  if (mb < 48) {
    float* sc = reinterpret_cast<float*>(lds);
    float* red = sc + 10240;
    for (int i = tid; i < 10240; i += NTHR) { const int b = i >> 10, k = i & 1023; const float v = b < 8 ? p.c_prompt[b * 1024 + k] : p.c_sample[(b - 8) * 1024 + k]; sc[i] = silu_f(v); }
    __syncthreads();
    const int col = tid & 63, kg = tid >> 6;
    float a0 = 0, a1 = 0, a2 = 0, a3 = 0, a4 = 0, a5 = 0, a6 = 0, a7 = 0, a8 = 0, a9 = 0;
#pragma unroll 16
    for (int k = kg * 128; k < kg * 128 + 128; ++k) {
      const float w = p.w_ada[(long)k * 3072 + mb * 64 + col];
      a0 += sc[k] * w; a1 += sc[1024 + k] * w; a2 += sc[2048 + k] * w; a3 += sc[3072 + k] * w; a4 += sc[4096 + k] * w;
      a5 += sc[5120 + k] * w; a6 += sc[6144 + k] * w; a7 += sc[7168 + k] * w; a8 += sc[8192 + k] * w; a9 += sc[9216 + k] * w;
    }
    float* rr = red + kg * 640 + col;
    rr[0] = a0; rr[64] = a1; rr[128] = a2; rr[192] = a3; rr[256] = a4; rr[320] = a5; rr[384] = a6; rr[448] = a7; rr[512] = a8; rr[576] = a9;
    __syncthreads();
    for (int i = tid; i < 640; i += NTHR) {
      float s = 0;
#pragma unroll
      for (int g = 0; g < 8; ++g) s += red[g * 640 + i];
      const int b = i >> 6, c = i & 63;
      reinterpret_cast<float*>(p.ws + OFF_MOD)[b * 3072 + mb * 64 + c] = s + p.b_ada[mb * 64 + c];
    }
    __syncthreads();
  }
}
__device__ __forceinline__ void phase0b(const Params& p) {
  int tid_ = threadIdx.x; asm volatile("" : "+v"(tid_));
  const int tid = tid_, wid = tid >> 6, lane = tid & 63;
  const float* mod = reinterpret_cast<const float*>(p.ws + OFF_MOD);
  bf16* h = (bf16*)(p.ws + OFF_H);
  const int nw = gridDim.x * 8;
  for (int row0 = blockIdx.x * 8 + wid; row0 < T; row0 += nw * 4) {
    float4 v[4][4];
#pragma unroll
    for (int q = 0; q < 4; ++q) {
      const int row = row0 + q * nw;
      if (row < T) {
        const float* xr = row < TP ? p.x_prompt + (long)row * DM : p.x_sample + (long)(row - TP) * DM;
#pragma unroll
        for (int i = 0; i < 4; ++i) v[q][i] = *reinterpret_cast<const float4*>(xr + i * 256 + lane * 4);
      }
    }
#pragma unroll
    for (int q = 0; q < 4; ++q) {
      const int row = row0 + q * nw;
      if (row < T) {
        const int bm = row < TP ? row >> 13 : 8 + ((row - TP) >> 14);
        float ss = 0;
#pragma unroll
        for (int i = 0; i < 4; ++i) ss += v[q][i].x * v[q][i].x + v[q][i].y * v[q][i].y + v[q][i].z * v[q][i].z + v[q][i].w * v[q][i].w;
#pragma unroll
        for (int m = 1; m < 64; m <<= 1) ss += __shfl_xor(ss, m);
        const float rs = rsqrtf(ss * (1.f / 1024.f) + EPS);
#pragma unroll
        for (int i = 0; i < 4; ++i) {
          const int c = i * 256 + lane * 4;
          const float4 g = *reinterpret_cast<const float4*>(p.g_pre + c);
          const float4 sh = *reinterpret_cast<const float4*>(mod + bm * 3072 + c), sc = *reinterpret_cast<const float4*>(mod + bm * 3072 + 1024 + c);
          st4(h + (long)row * DM + c, v[q][i].x * rs * g.x * (1.f + sc.x) + sh.x, v[q][i].y * rs * g.y * (1.f + sc.y) + sh.y,
              v[q][i].z * rs * g.z * (1.f + sc.z) + sh.z, v[q][i].w * rs * g.w * (1.f + sc.w) + sh.w);
        }
      }
    }
  }
}
__device__ __forceinline__ void phase4(const Params& p) {
  int tid_ = threadIdx.x; asm volatile("" : "+v"(tid_));
  const int tid = tid_, wid = tid >> 6, lane = tid & 63;
  const float* mod = reinterpret_cast<const float*>(p.ws + OFF_MOD);
  const bf16* ob = (const bf16*)(p.ws + OFF_OUTB);
  const float* sso = reinterpret_cast<const float*>(p.ws + OFF_SSO);
  const int nw = gridDim.x * 8;
  for (int row0 = blockIdx.x * 8 + wid; row0 < T; row0 += nw * 4) {
    float4 x[4][4]; uint2 ou[4][4]; float ssv[4];
#pragma unroll
    for (int q = 0; q < 4; ++q) {
      const int row = row0 + q * nw;
      if (row < T) {
        const float* xr = row < TP ? p.x_prompt + (long)row * DM : p.x_sample + (long)(row - TP) * DM;
        ssv[q] = lane < 32 ? sso[(long)row * 32 + lane] : 0.f;
#pragma unroll
        for (int i = 0; i < 4; ++i) { const int c = i * 256 + lane * 4; x[q][i] = *reinterpret_cast<const float4*>(xr + c); ou[q][i] = *reinterpret_cast<const uint2*>(ob + (long)row * DM + c); }
      }
    }
#pragma unroll
    for (int q = 0; q < 4; ++q) {
      const int row = row0 + q * nw;
      if (row < T) {
        const int bm = row < TP ? row >> 13 : 8 + ((row - TP) >> 14);
        float ss = ssv[q];
#pragma unroll
        for (int m = 1; m < 64; m <<= 1) ss += __shfl_xor(ss, m);
        const float rs = rsqrtf(ss * (1.f / 1024.f) + EPS);
#pragma unroll
        for (int i = 0; i < 4; ++i) {
          const int c = i * 256 + lane * 4;
          const float4 g = *reinterpret_cast<const float4*>(p.g_post + c), gt = *reinterpret_cast<const float4*>(mod + bm * 3072 + 2048 + c);
          float4 r;
          r.x = x[q][i].x + gt.x * (__uint_as_float(ou[q][i].x << 16) * rs * g.x);
          r.y = x[q][i].y + gt.y * (__uint_as_float(ou[q][i].x & 0xffff0000u) * rs * g.y);
          r.z = x[q][i].z + gt.z * (__uint_as_float(ou[q][i].y << 16) * rs * g.z);
          r.w = x[q][i].w + gt.w * (__uint_as_float(ou[q][i].y & 0xffff0000u) * rs * g.w);
          *reinterpret_cast<float4*>(p.out + (long)row * DM + c) = r;
        }
      }
    }
  }
}

__global__ void __launch_bounds__(NTHR) hymba_fwd(Params p) {
  extern __shared__ __attribute__((aligned(16))) char lds[];
  cg::grid_group grid = cg::this_grid();
  const int G = gridDim.x, bid = blockIdx.x;

#ifndef PM
#define PM 0xff
#endif
  if (PM & 1) phase0(p, lds);
  grid.sync();
  if (PM & 1) phase0b(p);
  grid.sync();
  for (int v = bid; v < 6528 + 255; v += G) {
    const int i = v & 255, k = v >> 8, st = k * 8 + (i & 7), id = st * 32 + (i >> 3);
    if ((PM & 2) && id < 6528) phase1_tile(p, id / 17, id % 17, lds);
  }
  grid.sync();
  if (PM & 4) for (int id = bid; id < 384 * 7; id += G) phase1b_tile(p, id / 7, id % 7, lds);
  grid.sync();
  for (int it = bid; it < 3072; it += G) {
    int cls, j;
    if (it < 512) { cls = 0; j = it; } else if (it < 1024) { cls = 1; j = it - 512; } else if (it < 2048) { cls = 2; j = it - 1024; } else { cls = 3; j = it - 2048; }
    const int i = j & 255, kk = j >> 8, xcd = i & 7, loc = i >> 3;
    const int isS = cls < 2;
    const int pair = isS ? xcd : kk * 8 + xcd, qb = isS ? kk * 32 + loc : loc;
    if (cls == 0 || cls == 2) { if (PM & 8) attnA_item(p, isS, pair, qb, lds); } else { if (PM & 16) attnB_item(p, isS, pair, qb, lds); }
  }
  grid.sync();
  if (PM & 32) for (int id = bid; id < 384 * 4; id += G) phase3_tile(p, id >> 2, id & 3, lds);
  grid.sync();
  if (PM & 64) phase4(p);
}

extern "C" void kernel_launch(void* const* d_in, const int* in_sizes, int n_in, void* d_out, int out_size, void* d_ws, size_t ws_size, hipStream_t stream) {
  static int grid_blocks = 0;
  if (!grid_blocks) {
    int dev = 0, cus = 0, per_cu = 0;
    hipGetDevice(&dev);
    hipDeviceGetAttribute(&cus, hipDeviceAttributeMultiprocessorCount, dev);
    hipFuncSetAttribute((const void*)hymba_fwd, hipFuncAttributeMaxDynamicSharedMemorySize, LDS_BYTES);
    hipOccupancyMaxActiveBlocksPerMultiprocessor(&per_cu, (const void*)hymba_fwd, NTHR, LDS_BYTES);
    if (per_cu < 1) per_cu = 1;
    if (per_cu > 1) per_cu = 1;
    grid_blocks = cus * per_cu;
    if (grid_blocks > 256) grid_blocks = 256;
  }
  Params p{};
  p.x_prompt = (const float*)d_in[0]; p.x_sample = (const float*)d_in[1]; p.c_prompt = (const float*)d_in[2]; p.c_sample = (const float*)d_in[3];
  p.w_ada = (const float*)d_in[4]; p.b_ada = (const float*)d_in[5]; p.g_pre = (const float*)d_in[6]; p.w_in = (const float*)d_in[7];
  p.lq1 = (const float*)d_in[8]; p.lk1 = (const float*)d_in[9]; p.lq2 = (const float*)d_in[10]; p.lk2 = (const float*)d_in[11];
  p.g_subln = (const float*)d_in[12]; p.g_cq = (const float*)d_in[13]; p.w_uq = (const float*)d_in[14]; p.g_ckv = (const float*)d_in[15];
  p.w_ukv = (const float*)d_in[16]; p.w_out = (const float*)d_in[17]; p.g_post = (const float*)d_in[18];
  p.out = (float*)d_out; p.ws = (char*)d_ws;
  void* args[] = {&p};
  hipError_t e = hipLaunchCooperativeKernel((const void*)hymba_fwd, dim3(grid_blocks), dim3(NTHR), args, LDS_BYTES, stream);
  if (e != hipSuccess) fprintf(stderr, "cooperative launch failed: %s (grid %d)\n", hipGetErrorString(e), grid_blocks);
}
```
